# Optimizing an MI355X kernel written in HIP

```python
import math
import jax, jax.numpy as jnp
from jax import lax
import numpy as np

D_MODEL = 1024
BATCH = 2
SEQ = 16384
DEPTH = 2

MEM_LEN = 256
EPS = 1e-6
LRU_WIDTH = 768
LRU_BLOCKS = 12
LRU_BLOCK = LRU_WIDTH // LRU_BLOCKS
LRU_CONV = 4
LRU_C = 8.0
ATT_HEADS = 12
HEAD_DIM = 64
ATT_WIDTH = ATT_HEADS * HEAD_DIM
DIL_GROUPS = ((128, 1), (512, 4), (2048, 16))
HEADS_PER_GROUP = ATT_HEADS // len(DIL_GROUPS)
ATT_OUT = HEADS_PER_GROUP * HEAD_DIM
Q_BLOCK = 128
ALIBI_SLOPES = tuple(2.0 ** (-8.0 * (h + 1) / ATT_HEADS) for h in range(ATT_HEADS))
SSM_WIDTH = 768
SSM_GROUP = 16
SSM_GROUPS = SSM_WIDTH // SSM_GROUP
SSM_STATE = 64
DT_MIN = 1e-3
DT_MAX = 1e-1
X_HEADS = 4
X_HEAD_DIM = 192
X_WIDTH = X_HEADS * X_HEAD_DIM
N_BRANCH = 4
D_FF = 3 * D_MODEL
FFN_CONV = 3
IN_SPLITS = (LRU_WIDTH, LRU_WIDTH, ATT_WIDTH, ATT_WIDTH, ATT_WIDTH, SSM_WIDTH, X_WIDTH, N_BRANCH * D_MODEL)
IN_WIDTH = sum(IN_SPLITS)
SPLIT_IDX = tuple(int(c) for c in np.cumsum(IN_SPLITS)[:-1])

kernel_name = 'hybrid_griffin_dilated_s5_block'


def rms_norm(x, g):
    xf = x.astype(jnp.float32)
    y = xf * lax.rsqrt(jnp.mean(xf * xf, axis=-1, keepdims=True) + EPS)
    return (y * g.astype(jnp.float32)).astype(x.dtype)


def causal_dwconv(x, w, b):
    K = w.shape[0]
    L = x.shape[1]
    xp = jnp.pad(x, ((0, 0), (K - 1, 0), (0, 0)))
    return b + sum(w[j] * xp[:, j:j + L] for j in range(K))


def _lin_combine(e1, e2):
    a1, b1 = e1
    a2, b2 = e2
    return a1 * a2, a2 * b1 + b2


def _cplx_combine(e1, e2):
    a1r, a1i, b1r, b1i = e1
    a2r, a2i, b2r, b2i = e2
    return (a2r * a1r - a2i * a1i, a2r * a1i + a2i * a1r,
            a2r * b1r - a2i * b1i + b2r, a2r * b1i + a2i * b1r + b2i)


def rg_lru_branch(xa, gate, conv_w, conv_b, wa, ba, wx, bx, lam):
    f32 = jnp.float32
    xc = causal_dwconv(xa, conv_w, conv_b)
    B_, L, W = xc.shape
    xb = xc.reshape(B_, L, LRU_BLOCKS, LRU_BLOCK)
    r = jax.nn.sigmoid((jnp.einsum('blni,nij->blnj', xb, wa).reshape(B_, L, W) + ba).astype(f32))
    i = jax.nn.sigmoid((jnp.einsum('blni,nij->blnj', xb, wx).reshape(B_, L, W) + bx).astype(f32))
    log_a = -LRU_C * r * jax.nn.softplus(-lam.astype(f32))
    a = jnp.exp(log_a)
    u = jnp.sqrt(-jnp.expm1(2.0 * log_a)) * (i * xc.astype(f32))
    _, h = lax.associative_scan(_lin_combine, (a, u), axis=1)
    return h.astype(xa.dtype) * jax.nn.gelu(gate)


def _to_strided(t, dil, n_pad):
    B_, L, H, E = t.shape
    n = L // dil
    t = t.reshape(B_, n, dil, H, E).transpose(0, 2, 1, 3, 4).reshape(B_ * dil, n, H, E)
    return jnp.pad(t, ((0, 0), (0, n_pad - n), (0, 0), (0, 0)))


def _band(t):
    prev = jnp.pad(t, ((0, 0), (1, 0), (0, 0), (0, 0), (0, 0)))[:, :-1]
    return jnp.concatenate([prev, t], axis=2)


def dilated_window_group(q, k, v, window, dil, slopes):
    f32 = jnp.float32
    B_, L, H, E = q.shape
    n = L // dil
    span = window // dil
    nb = -(-n // Q_BLOCK)
    n_pad = nb * Q_BLOCK
    qs = _to_strided(q, dil, n_pad).reshape(B_ * dil, nb, Q_BLOCK, H, E)
    kb = _band(_to_strided(k, dil, n_pad).reshape(B_ * dil, nb, Q_BLOCK, H, E))
    vb = _band(_to_strided(v, dil, n_pad).reshape(B_ * dil, nb, Q_BLOCK, H, E))
    s = jnp.einsum('znqhe,znkhe->znhqk', qs, kb).astype(f32) * (E ** -0.5)
    qi = jnp.arange(Q_BLOCK)[:, None]
    ki = jnp.arange(2 * Q_BLOCK)[None, :]
    dist = qi + Q_BLOCK - ki
    blk = jnp.arange(nb)[:, None, None]
    valid = (dist >= 0) & (dist <= span) & (blk * Q_BLOCK + ki - Q_BLOCK >= 0)
    bias = -(slopes * dil)[:, None, None] * dist.astype(f32)
    s = jnp.where(valid[None, :, None], s + bias[None, None], -jnp.inf)
    m = jnp.max(s, axis=-1, keepdims=True)
    p = jnp.exp(s - m)
    l = jnp.sum(p, axis=-1, keepdims=True)
    o = jnp.einsum('znhqk,znkhe->znqhe', p, vb.astype(f32)) / l.transpose(0, 1, 3, 2, 4)
    lse = (m + jnp.log(l))[..., 0].transpose(0, 1, 3, 2)
    o = o.reshape(B_, dil, n_pad, H, E)[:, :, :n].transpose(0, 2, 1, 3, 4).reshape(B_, L, H, E)
    lse = lse.reshape(B_, dil, n_pad, H)[:, :, :n].transpose(0, 2, 1, 3).reshape(B_, L, H)
    return o, lse


def dilated_attention(q, k, v):
    B_, L, _ = q.shape
    qh = q.reshape(B_, L, ATT_HEADS, HEAD_DIM)
    kh = k.reshape(B_, L, ATT_HEADS, HEAD_DIM)
    vh = v.reshape(B_, L, ATT_HEADS, HEAD_DIM)
    outs, lses = [], []
    for g, (window, dil) in enumerate(DIL_GROUPS):
        hs = slice(g * HEADS_PER_GROUP, (g + 1) * HEADS_PER_GROUP)
        slopes = jnp.asarray(ALIBI_SLOPES[hs], jnp.float32)
        o, lse = dilated_window_group(qh[:, :, hs], kh[:, :, hs], vh[:, :, hs], window, dil, slopes)
        outs.append(o)
        lses.append(lse)
    wts = jax.nn.softmax(jnp.stack(lses), axis=0)
    o = jnp.einsum('gblh,gblhe->blhe', wts, jnp.stack(outs))
    return o.reshape(B_, L, ATT_OUT).astype(q.dtype)


def s5_branch(u, a_re, a_im, log_dt, b_re, b_im, c_re, c_im, d_skip, w_glu):
    f32 = jnp.float32
    B_, L, W = u.shape
    dt = jnp.exp(log_dt.astype(f32))[:, None]
    lr, li = a_re.astype(f32), a_im.astype(f32)
    mag = jnp.exp(lr * dt)
    ab_re, ab_im = mag * jnp.cos(li * dt), mag * jnp.sin(li * dt)
    den = lr * lr + li * li
    z_re = ((ab_re - 1.0) * lr + ab_im * li) / den
    z_im = (ab_im * lr - (ab_re - 1.0) * li) / den
    br, bi = b_re.astype(f32), b_im.astype(f32)
    bb_re = z_re[..., None] * br - z_im[..., None] * bi
    bb_im = z_re[..., None] * bi + z_im[..., None] * br
    ut = u.astype(f32).reshape(B_, L, SSM_GROUPS, SSM_GROUP).transpose(1, 0, 2, 3)
    bu_re = jnp.einsum('gph,lbgh->lbgp', bb_re, ut)
    bu_im = jnp.einsum('gph,lbgh->lbgp', bb_im, ut)
    a_r = jnp.broadcast_to(ab_re[None, None], (L, 1, SSM_GROUPS, SSM_STATE))
    a_i = jnp.broadcast_to(ab_im[None, None], (L, 1, SSM_GROUPS, SSM_STATE))
    _, _, xr, xi = lax.associative_scan(_cplx_combine, (a_r, a_i, bu_re, bu_im), axis=0)
    y = (jnp.einsum('ghp,lbgp->blgh', c_re.astype(f32), xr)
         - jnp.einsum('ghp,lbgp->blgh', c_im.astype(f32), xi)).reshape(B_, L, W)
    y = (y + d_skip.astype(f32) * u.astype(f32)).astype(u.dtype)
    zg = jax.nn.gelu(y) @ w_glu
    return zg[..., :W] * jax.nn.sigmoid(zg[..., W:])


def memory_cross_attention(q, mem_n, w_kv):
    B_, L, _ = q.shape
    M = mem_n.shape[1]
    kv = mem_n @ w_kv
    kh = kv[..., :X_WIDTH].reshape(B_, M, X_HEADS, X_HEAD_DIM)
    vh = kv[..., X_WIDTH:].reshape(B_, M, X_HEADS, X_HEAD_DIM)
    qh = q.reshape(B_, L, X_HEADS, X_HEAD_DIM)
    s = jnp.einsum('blhe,bmhe->bhlm', qh, kh).astype(jnp.float32) * (X_HEAD_DIM ** -0.5)
    p = jax.nn.softmax(s, axis=-1)
    o = jnp.einsum('bhlm,bmhe->blhe', p.astype(vh.dtype), vh)
    return o.reshape(B_, L, X_WIDTH)


def mixing_sublayer(h, mem_n, w_in, lru_conv_w, lru_conv_b, lru_wa, lru_ba, lru_wx, lru_bx, lru_lambda,
                    ssm_a_re, ssm_a_im, ssm_log_dt, ssm_b_re, ssm_b_im, ssm_c_re, ssm_c_im, ssm_d, ssm_glu,
                    mem_wkv, proj_a, proj_b, proj_c, proj_x, w_out):
    B_, L, _ = h.shape
    z = h @ w_in
    xa, ga, q, k, v, us, xq, gates = jnp.split(z, SPLIT_IDX, axis=-1)
    ya = rg_lru_branch(xa, ga, lru_conv_w, lru_conv_b, lru_wa, lru_ba, lru_wx, lru_bx, lru_lambda)
    yb = dilated_attention(q, k, v)
    yc = s5_branch(us, ssm_a_re, ssm_a_im, ssm_log_dt, ssm_b_re, ssm_b_im, ssm_c_re, ssm_c_im, ssm_d, ssm_glu)
    yx = memory_cross_attention(xq, mem_n, mem_wkv)
    g = jax.nn.sigmoid(gates.reshape(B_, L, N_BRANCH, D_MODEL))
    m = (g[:, :, 0] * (ya @ proj_a) + g[:, :, 1] * (yb @ proj_b)
         + g[:, :, 2] * (yc @ proj_c) + g[:, :, 3] * (yx @ proj_x))
    return m @ w_out


def conv_gated_mlp(h, w_up, conv_w, conv_b, w_down):
    up = h @ w_up
    val = up[..., :D_FF]
    gate = causal_dwconv(up[..., D_FF:], conv_w, conv_b)
    return (val * jax.nn.gelu(gate)) @ w_down


def setup_inputs(seed: int = 0) -> dict:
    key = jax.random.key(seed)
    ks = iter(jax.random.split(key, 48))
    f32 = jnp.float32

    def nrm(shape, scale):
        return scale * jax.random.normal(next(ks), shape, f32)

    def gain():
        return 1.0 + nrm((DEPTH, D_MODEL), 0.02)

    x = nrm((BATCH, SEQ, D_MODEL), 1.0)
    mem = nrm((BATCH, MEM_LEN, D_MODEL), 1.0)
    g_mix_pre, g_mix_post, g_mem, g_mlp_pre, g_mlp_post = gain(), gain(), gain(), gain(), gain()
    w_in = nrm((DEPTH, D_MODEL, IN_WIDTH), D_MODEL ** -0.5)
    lru_conv_w = nrm((DEPTH, LRU_CONV, LRU_WIDTH), LRU_CONV ** -0.5)
    lru_conv_b = nrm((DEPTH, LRU_WIDTH), 0.02)
    lru_wa = nrm((DEPTH, LRU_BLOCKS, LRU_BLOCK, LRU_BLOCK), LRU_BLOCK ** -0.5)
    lru_ba = nrm((DEPTH, LRU_WIDTH), 0.02)
    lru_wx = nrm((DEPTH, LRU_BLOCKS, LRU_BLOCK, LRU_BLOCK), LRU_BLOCK ** -0.5)
    lru_bx = nrm((DEPTH, LRU_WIDTH), 0.02)
    a_c = jax.random.uniform(next(ks), (DEPTH, LRU_WIDTH), f32, 0.9, 0.999)
    a0 = a_c ** (1.0 / LRU_C)
    lru_lambda = jnp.log(a0) - jnp.log1p(-a0)
    ssm_a_re = -0.5 + nrm((DEPTH, SSM_GROUPS, SSM_STATE), 0.01)
    ssm_a_im = jnp.pi * jnp.arange(SSM_STATE, dtype=f32) + nrm((DEPTH, SSM_GROUPS, SSM_STATE), 0.01)
    ssm_log_dt = jax.random.uniform(next(ks), (DEPTH, SSM_GROUPS), f32, math.log(DT_MIN), math.log(DT_MAX))
    ssm_b_re = nrm((DEPTH, SSM_GROUPS, SSM_STATE, SSM_GROUP), (2.0 * SSM_GROUP) ** -0.5)
    ssm_b_im = nrm((DEPTH, SSM_GROUPS, SSM_STATE, SSM_GROUP), (2.0 * SSM_GROUP) ** -0.5)
    ssm_c_re = nrm((DEPTH, SSM_GROUPS, SSM_GROUP, SSM_STATE), (2.0 * SSM_STATE) ** -0.5)
    ssm_c_im = nrm((DEPTH, SSM_GROUPS, SSM_GROUP, SSM_STATE), (2.0 * SSM_STATE) ** -0.5)
    ssm_d = nrm((DEPTH, SSM_WIDTH), 1.0)
    ssm_glu = nrm((DEPTH, SSM_WIDTH, 2 * SSM_WIDTH), SSM_WIDTH ** -0.5)
    mem_wkv = nrm((DEPTH, D_MODEL, 2 * X_WIDTH), D_MODEL ** -0.5)
    proj_a = nrm((DEPTH, LRU_WIDTH, D_MODEL), LRU_WIDTH ** -0.5)
    proj_b = nrm((DEPTH, ATT_OUT, D_MODEL), ATT_OUT ** -0.5)
    proj_c = nrm((DEPTH, SSM_WIDTH, D_MODEL), SSM_WIDTH ** -0.5)
    proj_x = nrm((DEPTH, X_WIDTH, D_MODEL), X_WIDTH ** -0.5)
    w_out = nrm((DEPTH, D_MODEL, D_MODEL), D_MODEL ** -0.5)
    ffn_w_up = nrm((DEPTH, D_MODEL, 2 * D_FF), D_MODEL ** -0.5)
    ffn_conv_w = nrm((DEPTH, FFN_CONV, D_FF), FFN_CONV ** -0.5)
    ffn_conv_b = nrm((DEPTH, D_FF), 0.02)
    ffn_w_down = nrm((DEPTH, D_FF, D_MODEL), D_FF ** -0.5)
    return {'x': x, 'mem': mem, 'g_mix_pre': g_mix_pre, 'g_mix_post': g_mix_post, 'g_mem': g_mem,
            'g_mlp_pre': g_mlp_pre, 'g_mlp_post': g_mlp_post, 'w_in': w_in,
            'lru_conv_w': lru_conv_w, 'lru_conv_b': lru_conv_b, 'lru_wa': lru_wa, 'lru_ba': lru_ba,
            'lru_wx': lru_wx, 'lru_bx': lru_bx, 'lru_lambda': lru_lambda,
            'ssm_a_re': ssm_a_re, 'ssm_a_im': ssm_a_im, 'ssm_log_dt': ssm_log_dt,
            'ssm_b_re': ssm_b_re, 'ssm_b_im': ssm_b_im, 'ssm_c_re': ssm_c_re, 'ssm_c_im': ssm_c_im,
            'ssm_d': ssm_d, 'ssm_glu': ssm_glu, 'mem_wkv': mem_wkv,
            'proj_a': proj_a, 'proj_b': proj_b, 'proj_c': proj_c, 'proj_x': proj_x, 'w_out': w_out,
            'ffn_w_up': ffn_w_up, 'ffn_conv_w': ffn_conv_w, 'ffn_conv_b': ffn_conv_b, 'ffn_w_down': ffn_w_down}


def reference(x, mem, g_mix_pre, g_mix_post, g_mem, g_mlp_pre, g_mlp_post, w_in,
              lru_conv_w, lru_conv_b, lru_wa, lru_ba, lru_wx, lru_bx, lru_lambda,
              ssm_a_re, ssm_a_im, ssm_log_dt, ssm_b_re, ssm_b_im, ssm_c_re, ssm_c_im,
              ssm_d, ssm_glu, mem_wkv, proj_a, proj_b, proj_c, proj_x, w_out,
              ffn_w_up, ffn_conv_w, ffn_conv_b, ffn_w_down):
    for l in range(DEPTH):
        h = rms_norm(x, g_mix_pre[l])
        mem_n = rms_norm(mem, g_mem[l])
        y = mixing_sublayer(h, mem_n, w_in[l], lru_conv_w[l], lru_conv_b[l], lru_wa[l], lru_ba[l],
                            lru_wx[l], lru_bx[l], lru_lambda[l],
                            ssm_a_re[l], ssm_a_im[l], ssm_log_dt[l], ssm_b_re[l], ssm_b_im[l],
                            ssm_c_re[l], ssm_c_im[l], ssm_d[l], ssm_glu[l],
                            mem_wkv[l], proj_a[l], proj_b[l], proj_c[l], proj_x[l], w_out[l])
        x = x + rms_norm(y, g_mix_post[l])
        h = rms_norm(x, g_mlp_pre[l])
        y = conv_gated_mlp(h, ffn_w_up[l], ffn_conv_w[l], ffn_conv_b[l], ffn_w_down[l])
        x = x + rms_norm(y, g_mlp_post[l])
    return x
```

```cpp
#include <hip/hip_runtime.h>
#include <hip/hip_cooperative_groups.h>
#include <cstdio>
namespace cg = cooperative_groups;

#ifndef ONLY_S
#define ONLY_S -1
#endif
#ifndef PHMASK
#define PHMASK 0xFFFFF
#endif
#define PH_ON(k) ((ONLY_S < 0 || ONLY_S == (k)) && ((PHMASK >> ((k) >= 100 ? (k) - 84 : (k))) & 1))
#ifndef DUPMASK
#define DUPMASK 0
#endif
#ifndef DUPMIX
#define DUPMIX 0
#endif
#define DM(k) for (int _rp = 0; _rp < 1 + ((DUPMIX >> (k)) & 1); ++_rp)
#ifndef MK_SINGLE
#define MK_SINGLE 1
#endif

constexpr int LSEQ = 16384, DM = 1024, NBATCH = 2, NIN = 9472, MEMLEN = 256;
constexpr int ZAW = 5376, ZGW = 4160;
constexpr int OFF_XA = 0, OFF_GA = 768, OFF_Q = 1536, OFF_K = 2304, OFF_V = 3072, OFF_US = 3840, OFF_XQ = 4608;
constexpr int DFF = 3072;
constexpr int S5_LC = 128, S5_NCH = LSEQ / S5_LC;
constexpr int LRU_LC = 128, LRU_NCH = LSEQ / LRU_LC;
constexpr float EPS = 1e-6f;
constexpr int LDS_BYTES = 135168 + 16;

typedef unsigned short bf16_t;
typedef short bf16x8 __attribute__((ext_vector_type(8)));
typedef float f32x4 __attribute__((ext_vector_type(4)));
typedef unsigned u32x4 __attribute__((ext_vector_type(4)));
typedef unsigned u32x2 __attribute__((ext_vector_type(2)));

__device__ __forceinline__ unsigned cvt_pk_bf16(float lo, float hi) { unsigned r; asm volatile("v_cvt_pk_bf16_f32 %0, %1, %2" : "=v"(r) : "v"(lo), "v"(hi)); return r; }
__device__ __forceinline__ bf16_t f2bf(float f) { unsigned u = __float_as_uint(f); u += 0x7FFFu + ((u >> 16) & 1u); return (bf16_t)(u >> 16); }
__device__ __forceinline__ float bf2f(bf16_t b) { return __uint_as_float(((unsigned)b) << 16); }
__device__ __forceinline__ float bflo(unsigned w) { return __uint_as_float(w << 16); }
__device__ __forceinline__ float bfhi(unsigned w) { return __uint_as_float(w & 0xffff0000u); }
__device__ __forceinline__ float fexp(float x) { return __builtin_amdgcn_exp2f(x * 1.4426950408889634f); }
__device__ __forceinline__ float sigmoidf_(float x) { return __builtin_amdgcn_rcpf(1.0f + fexp(-x)); }
__device__ __forceinline__ float gelu_tanh(float x) { const float u = -2.3022081302f * (x + 0.044715f * x * x * x); return x * __builtin_amdgcn_rcpf(1.0f + __builtin_amdgcn_exp2f(u)); }

struct Args {
    const float* in[34];
    float* out;
    unsigned char* ws;
    int ph_lo, ph_hi;
};
enum { I_X = 0, I_MEM, I_GMIXPRE, I_GMIXPOST, I_GMEM, I_GMLPPRE, I_GMLPPOST, I_WIN, I_LCW, I_LCB, I_LWA, I_LBA, I_LWX, I_LBX, I_LLAM,
       I_SARE, I_SAIM, I_SLOGDT, I_SBRE, I_SBIM, I_SCRE, I_SCIM, I_SD, I_SGLU, I_MEMWKV, I_PA, I_PB, I_PC, I_PX, I_WOUT, I_FUP, I_FCW, I_FCB, I_FDOWN };

__device__ __forceinline__ int opq_s(int v) { asm volatile("" : "+s"(v)); return v; }
__device__ __forceinline__ int tidx() { int v = (int)threadIdx.x; asm volatile("" : "+v"(v)); return v; }
#define GAS __attribute__((address_space(1)))
__device__ __forceinline__ size_t opq0() { size_t z = 0; asm volatile("" : "+s"(z)); return z; }
__device__ __forceinline__ unsigned char* wsp(const Args& a) { return a.ws + opq0(); }
__device__ __forceinline__ float* outp(const Args& a) { return a.out + opq0(); }
__device__ __forceinline__ const float* inp(const Args& a, int k) { return a.in[k] + opq0(); }
constexpr size_t al256(size_t x) { return (x + 255) & ~(size_t)255; }
constexpr size_t WS_WINT = 0;
constexpr size_t WS_GLUT = WS_WINT + (size_t)NIN * 1024 * 2;
constexpr size_t WS_WKVT = WS_GLUT + (size_t)1536 * 768 * 2;
constexpr size_t WS_PAT = WS_WKVT + (size_t)1536 * 1024 * 2;
constexpr size_t WS_PBT = WS_PAT + (size_t)1024 * 768 * 2;
constexpr size_t WS_PCT = WS_PBT + (size_t)1024 * 256 * 2;
constexpr size_t WS_PXT = WS_PCT + (size_t)1024 * 768 * 2;
constexpr size_t WS_WOUTT = WS_PXT + (size_t)1024 * 768 * 2;
constexpr size_t WS_UPT = WS_WOUTT + (size_t)1024 * 1024 * 2;
constexpr size_t WS_DOWNT = WS_UPT + (size_t)6144 * 1024 * 2;
constexpr size_t WS_WAT = WS_DOWNT + (size_t)1024 * 3072 * 2;
constexpr size_t WS_WXT = WS_WAT + (size_t)12 * 4096 * 2;
constexpr size_t WS_ABAR = WS_WXT + (size_t)12 * 4096 * 2;
constexpr size_t WS_ABARL = WS_ABAR + (size_t)48 * 64 * 2 * 4;
constexpr size_t WS_BBART = WS_ABARL + (size_t)48 * 64 * 2 * 4;
constexpr size_t WS_CMAT = WS_BBART + (size_t)48 * 128 * 16 * 2;
constexpr size_t WS_MEMN = WS_CMAT + (size_t)48 * 16 * 128 * 2;
constexpr size_t WS_KVM = WS_MEMN + (size_t)512 * 1024 * 2;
constexpr size_t WS_S5C = WS_KVM + (size_t)512 * 1536 * 2;
constexpr size_t WS_LRUP = WS_S5C + (size_t)S5_NCH * 48 * 64 * 2 * 4;
constexpr size_t WS_LRUH = WS_LRUP + (size_t)LRU_NCH * 768 * 4;
constexpr size_t WS_HB = al256(WS_LRUH + (size_t)LRU_NCH * 768 * 4);
constexpr size_t WS_Z = WS_HB + (size_t)LSEQ * 1024 * 2;
constexpr size_t WS_ZA = WS_Z;
constexpr size_t WS_ZG = WS_ZA + (size_t)LSEQ * ZAW * 2;
constexpr size_t WS_UP = WS_Z;
constexpr size_t WS_ACT = WS_UP + (size_t)LSEQ * 6144 * 2;
constexpr size_t WS_MB = WS_ZA;
constexpr size_t WS_YOUT1 = WS_MB + (size_t)LSEQ * 1024 * 2;
constexpr size_t WS_Y = WS_ZG + (size_t)LSEQ * ZGW * 2;
constexpr size_t WS_OATT = WS_HB;
constexpr size_t WS_LSE = WS_Y;
constexpr size_t WS_GY = WS_LSE + (size_t)LSEQ * 12 * 4;
constexpr size_t WS_YCAT = WS_GY + (size_t)LSEQ * 768 * 2;
constexpr int YCW = 2560, YC_A = 0, YC_B = 768, YC_C = 1024, YC_X = 1792;
constexpr size_t WS_YOUT2 = WS_Y;
constexpr size_t WS_BAR = WS_YCAT + (size_t)LSEQ * YCW * 2;
constexpr size_t WS_END = WS_BAR + 16384;
static_assert(WS_ACT + (size_t)LSEQ * 3072 * 2 <= WS_Y, "up/act alias overflow");
static_assert(WS_YOUT1 + (size_t)LSEQ * 1024 * 4 <= WS_ZG, "mb/yout alias overflow");
static_assert(WS_YOUT2 + (size_t)LSEQ * 1024 * 4 <= WS_END, "yout2 alias overflow");
static_assert(WS_END <= (size_t)512 * 1024 * 1024, "workspace too large");

namespace pg8 {
#define PG8_LAS __attribute__((address_space(3)))
constexpr int BM = 256, BK = 64, HALF = 128, HTB = HALF * BK * 2, STAGE_BYTES = 8 * HTB, NXCD = 8, WGM = 4;
__host__ __device__ __forceinline__ int lds_byte(int r, int c) { const int st = (r >> 4) * 2 + (c >> 5), rr = r & 15, cc = c & 31, ob = rr * 64 + cc * 2; return st * 1024 + (ob ^ (((ob >> 9) & 1) << 5)); }
__host__ __device__ __forceinline__ void stage_rc(int b, int& R, int& C) { const int st = b / 1024, sb = b % 1024, swz = sb ^ (((sb >> 9) & 1) << 5); R = (st >> 1) * 16 + swz / 64; C = (st & 1) * 32 + (swz % 64) / 2; }
__host__ __device__ __forceinline__ int perm32(int rho) { const int n = rho >> 4, i = rho & 15; return 8 * (i >> 2) + 4 * n + (i & 3); }
struct Unit { int pm, pn; };
struct Gemm { const bf16_t* A; const bf16_t* Bt; int M, N, K; };
struct StaticOrder {
    int nM, nN, nwg, G, c;
    __device__ void init(int M, int N, int G_, int c_) { nM = M / BM; nN = N / BM; nwg = nM * nN; G = G_; c = c_; }
    __device__ bool next(int i, Unit& u) const {
        const long L = (long)i * G + c; if (L >= nwg) return false;
        int wgid = (int)L; { const int q = nwg / NXCD, r = nwg % NXCD, xcd = wgid % NXCD, off = wgid / NXCD; wgid = (xcd < r ? xcd * (q + 1) : r * (q + 1) + (xcd - r) * q) + off; }
        const int nig = WGM * nN, gid = wgid / nig, fm = gid * WGM, gsz = (nM - fm) < WGM ? (nM - fm) : WGM;
        u.pm = fm + ((wgid % nig) % gsz); u.pn = (wgid % nig) / gsz; return true;
    }
};
template <class Epi>
__device__ __forceinline__ void gemm_phase(PG8_LAS unsigned char* lds, const Gemm g, const StaticOrder& S, const Epi& E) {
    const int tid = tidx(), wid = __builtin_amdgcn_readfirstlane(tid >> 6), lane = tid & 63, wr = wid >> 2, wc = wid & 3, fr = lane & 15, fq = lane >> 4;
    const int K = g.K, nt = K / BK;
    unsigned voffA[2], voffB[2];
#pragma unroll
    for (int i = 0; i < 2; ++i) { int R, C; stage_rc(tid * 16 + i * 8192, R, C); const int Rb = (R & ~31) + perm32(R & 31); voffA[i] = (unsigned)(R * K + C) * 2u; voffB[i] = (unsigned)(Rb * K + C) * 2u; }
    const size_t kstep = (size_t)(BK * 2);
    const size_t hstep = (size_t)HALF * K * 2;
    const size_t tstep = 2 * hstep;
    const unsigned ldsw = (unsigned)wid * 1024u;
    const int aoff = lds_byte(wr * 64 + fr, fq * 8), boff = lds_byte(wc * 32 + fr, fq * 8);
#define PG8_SA(b, h) (((b) * 2 + (h)) * HTB)
#define PG8_SB(b, h) ((4 + (b) * 2 + (h)) * HTB)
#define PG8_STAGE(bufoff, gbase, voff) do { _Pragma("unroll") for (int _i = 0; _i < 2; ++_i) \
        __builtin_amdgcn_global_load_lds((const unsigned*)((const char*)(gbase) + (voff)[_i]), (PG8_LAS unsigned*)(lds + (bufoff) + ldsw + _i * 8192), 16, 0, 0); } while (0)
#define PG8_LDA(dst, b, h) do { _Pragma("unroll") for (int m = 0; m < 4; ++m) _Pragma("unroll") for (int k = 0; k < 2; ++k) dst[m][k] = *(const PG8_LAS bf16x8*)(lds + PG8_SA(b, h) + aoff + m * 2048 + k * 1024); } while (0)
#define PG8_LDB(dst, b, h) do { _Pragma("unroll") for (int n = 0; n < 2; ++n) _Pragma("unroll") for (int k = 0; k < 2; ++k) dst[n][k] = *(const PG8_LAS bf16x8*)(lds + PG8_SB(b, h) + boff + n * 2048 + k * 1024); } while (0)
#define PG8_MMA(ai, bj, At, Bt) do { __builtin_amdgcn_s_setprio(3); _Pragma("unroll") for (int m = 0; m < 4; ++m) _Pragma("unroll") for (int n = 0; n < 2; ++n) _Pragma("unroll") for (int k = 0; k < 2; ++k) \
        acc[ai][bj][m][n] = __builtin_amdgcn_mfma_f32_16x16x32_bf16(Bt[n][k], At[m][k], acc[ai][bj][m][n], 0, 0, 0); __builtin_amdgcn_s_setprio(0); } while (0)
#define PG8_WAIT_V(n) asm volatile("s_waitcnt vmcnt(" #n ")" ::: "memory")
#define PG8_WAIT_L(n) asm volatile("s_waitcnt lgkmcnt(" #n ")" ::: "memory")
#define PG8_BAR __builtin_amdgcn_s_barrier()
#define PG8_SCHED __builtin_amdgcn_sched_barrier(0)
    Unit cur, nxt; int ui = 0;
    if (!S.next(0, cur)) return;
    f32x4 acc[2][2][4][2];
#pragma unroll
    for (int a = 0; a < 2; ++a)
#pragma unroll
        for (int b = 0; b < 2; ++b)
#pragma unroll
            for (int m = 0; m < 4; ++m)
#pragma unroll
                for (int n = 0; n < 2; ++n) acc[a][b][m][n] = (f32x4){0.f, 0.f, 0.f, 0.f};
    bf16x8 At[4][2], B0[2][2], B1[2][2];
    const char* cA = (const char*)g.A + (size_t)cur.pm * tstep; const char* cB = (const char*)g.Bt + (size_t)cur.pn * tstep;
    PG8_STAGE(PG8_SB(0, 0), cB, voffB); PG8_STAGE(PG8_SB(0, 1), cB + hstep, voffB); PG8_STAGE(PG8_SA(0, 0), cA, voffA); PG8_STAGE(PG8_SA(0, 1), cA + hstep, voffA);
    if (wr == 1) PG8_BAR;
    PG8_WAIT_V(2); PG8_BAR;
    PG8_STAGE(PG8_SB(1, 0), cB + kstep, voffB); PG8_STAGE(PG8_SA(1, 0), cA + kstep, voffA); PG8_STAGE(PG8_SB(1, 1), cB + hstep + kstep, voffB);
    PG8_WAIT_V(6); PG8_BAR;
    for (;;) {
        const bool has_next = S.next(ui + 1, nxt);
        const char* nA = has_next ? (const char*)g.A + (size_t)nxt.pm * tstep : cA; const char* nB = has_next ? (const char*)g.Bt + (size_t)nxt.pn * tstep : cB;
        for (int t = 0; t < nt; t += 2) {
            const bool last = (t == nt - 2);
            E.mid(acc, cur, t, wr, wc, fr, fq);
            const char* a1 = cA + (size_t)(t + 1) * kstep;
            const char* a2 = last ? nA : cA + (size_t)(t + 2) * kstep; const char* b2 = last ? nB : cB + (size_t)(t + 2) * kstep;
            const char* a3 = a2 + kstep; const char* b3 = b2 + kstep;
            PG8_LDB(B0, 0, 0); PG8_LDB(B1, 0, 1); PG8_SCHED; PG8_LDA(At, 0, 0); PG8_STAGE(PG8_SA(1, 1), a1 + hstep, voffA);
            PG8_WAIT_V(8); PG8_WAIT_L(0); PG8_BAR; PG8_MMA(0, 0, At, B0); PG8_MMA(0, 1, At, B1); PG8_BAR; PG8_SCHED;
            PG8_LDA(At, 0, 1); PG8_STAGE(PG8_SB(0, 0), b2, voffB); PG8_STAGE(PG8_SB(0, 1), b2 + hstep, voffB); PG8_STAGE(PG8_SA(0, 0), a2, voffA);
            PG8_WAIT_V(8); PG8_WAIT_L(0); PG8_BAR; PG8_MMA(1, 0, At, B0); PG8_MMA(1, 1, At, B1); PG8_BAR; PG8_SCHED;
            PG8_LDB(B0, 1, 0); PG8_LDB(B1, 1, 1); PG8_SCHED; PG8_LDA(At, 1, 0); PG8_STAGE(PG8_SA(0, 1), a2 + hstep, voffA);
            PG8_WAIT_V(8); PG8_WAIT_L(0); PG8_BAR; PG8_MMA(0, 0, At, B0); PG8_MMA(0, 1, At, B1); PG8_BAR; PG8_SCHED;
            PG8_LDA(At, 1, 1); PG8_STAGE(PG8_SB(1, 0), b3, voffB); PG8_STAGE(PG8_SB(1, 1), b3 + hstep, voffB); PG8_STAGE(PG8_SA(1, 0), a3, voffA);
            PG8_WAIT_V(8); PG8_WAIT_L(0); PG8_BAR; PG8_MMA(1, 0, At, B0); PG8_MMA(1, 1, At, B1); PG8_BAR; PG8_SCHED;
        }
        if (wr == 0) PG8_BAR;
        E(acc, cur, wr, wc, fr, fq);
        if (!has_next) break;
#pragma unroll
        for (int a = 0; a < 2; ++a)
#pragma unroll
            for (int b = 0; b < 2; ++b)
#pragma unroll
                for (int m = 0; m < 4; ++m)
#pragma unroll
                    for (int n = 0; n < 2; ++n) acc[a][b][m][n] = (f32x4){0.f, 0.f, 0.f, 0.f};
        cur = nxt; cA = nA; cB = nB; ++ui;
        if (wr == 1) PG8_BAR;
    }
    PG8_WAIT_V(0);
    PG8_BAR;
#undef PG8_SA
#undef PG8_SB
#undef PG8_STAGE
#undef PG8_LDA
#undef PG8_LDB
#undef PG8_MMA
#undef PG8_WAIT_V
#undef PG8_WAIT_L
#undef PG8_BAR
#undef PG8_SCHED
}
}

typedef f32x4 AccT[2][2][4][2];

__device__ __forceinline__ u32x4 pack8(const f32x4& a, const f32x4& b) { u32x4 w; w[0] = cvt_pk_bf16(a[0], a[1]); w[1] = cvt_pk_bf16(a[2], a[3]); w[2] = cvt_pk_bf16(b[0], b[1]); w[3] = cvt_pk_bf16(b[2], b[3]); return w; }
struct EpiWin {
    bf16_t* zA; bf16_t* zG;
    __device__ __forceinline__ void operator()(const AccT& acc, const pg8::Unit& u, int wr, int wc, int fr, int fq) const {
        const int row0 = u.pm * 256 + wr * 64 + fr;
        const int pn = u.pn;
        bf16_t* base; int ld, colt, mode;
        if (pn < 21) { base = zA; ld = ZAW; colt = pn * 256; mode = (pn >= 3 && pn < 6) ? 1 : 0; }
        else { base = zG; ld = ZGW; colt = (pn - 21) * 256; mode = 2; }
        const int col0 = colt + wc * 32 + 8 * fq;
#pragma unroll
        for (int ai = 0; ai < 2; ++ai)
#pragma unroll
            for (int m = 0; m < 4; ++m) {
                bf16_t* rowp = base + (size_t)(row0 + ai * 128 + m * 16) * ld + col0;
#pragma unroll
                for (int bj = 0; bj < 2; ++bj) {
                    f32x4 v0 = acc[ai][bj][m][0], v1 = acc[ai][bj][m][1];
                    if (mode == 1) {
#pragma unroll
                        for (int i = 0; i < 4; ++i) { v0[i] = gelu_tanh(v0[i]); v1[i] = gelu_tanh(v1[i]); }
                    } else if (mode == 2) {
#pragma unroll
                        for (int i = 0; i < 4; ++i) { v0[i] = sigmoidf_(v0[i]); v1[i] = sigmoidf_(v1[i]); }
                    }
                    *(u32x4*)(rowp + bj * 128) = pack8(v0, v1);
                }
            }
    }
};
struct EpiBf16 {
    bf16_t* O; int ld;
    __device__ __forceinline__ void operator()(const AccT& acc, const pg8::Unit& u, int wr, int wc, int fr, int fq) const {
        const int row0 = u.pm * 256 + wr * 64 + fr, col0 = u.pn * 256 + wc * 32 + 8 * fq;
#pragma unroll
        for (int ai = 0; ai < 2; ++ai)
#pragma unroll
            for (int m = 0; m < 4; ++m) {
                bf16_t* rowp = O + (size_t)(row0 + ai * 128 + m * 16) * ld + col0;
#pragma unroll
                for (int bj = 0; bj < 2; ++bj) *(u32x4*)(rowp + bj * 128) = pack8(acc[ai][bj][m][0], acc[ai][bj][m][1]);
            }
    }
};
struct EpiF32 {
    float* C; int ld;
    __device__ __forceinline__ void operator()(const AccT& acc, const pg8::Unit& u, int wr, int wc, int fr, int fq) const {
        const int row0 = u.pm * 256 + wr * 64 + fr, col0 = u.pn * 256 + wc * 32 + 8 * fq;
#pragma unroll
        for (int ai = 0; ai < 2; ++ai)
#pragma unroll
            for (int m = 0; m < 4; ++m) {
                float* rowp = C + (size_t)(row0 + ai * 128 + m * 16) * ld + col0;
#pragma unroll
                for (int bj = 0; bj < 2; ++bj) { *(f32x4*)(rowp + bj * 128) = acc[ai][bj][m][0]; *(f32x4*)(rowp + bj * 128 + 4) = acc[ai][bj][m][1]; }
            }
    }
};
struct EpiGlu {
    bf16_t* O;
    __device__ __forceinline__ void operator()(const AccT& acc, const pg8::Unit& u, int wr, int wc, int fr, int fq) const {
        const int row0 = u.pm * 256 + wr * 64 + fr, col0 = u.pn * 128 + wc * 32 + 8 * fq;
#pragma unroll
        for (int ai = 0; ai < 2; ++ai)
#pragma unroll
            for (int m = 0; m < 4; ++m) {
                bf16_t* rowp = O + (size_t)(row0 + ai * 128 + m * 16) * YCW + col0;
                f32x4 o0, o1;
#pragma unroll
                for (int i = 0; i < 4; ++i) { o0[i] = acc[ai][0][m][0][i] * sigmoidf_(acc[ai][1][m][0][i]); o1[i] = acc[ai][0][m][1][i] * sigmoidf_(acc[ai][1][m][1][i]); }
                *(u32x4*)(rowp) = pack8(o0, o1);
            }
    }
};
struct EpiMergeF {
    bf16_t* mb; const bf16_t* zG;
    __device__ __forceinline__ void rescale(AccT& acc, const pg8::Unit& u, int b, int wr, int wc, int fr, int fq) const {
        int zz = 0; asm volatile("" : "+v"(zz));
        const int row0 = u.pm * 256 + wr * 64 + fr + zz, col0 = u.pn * 256 + wc * 32 + 8 * fq;
#pragma unroll
        for (int ai = 0; ai < 2; ++ai)
#pragma unroll
            for (int m = 0; m < 4; ++m) {
                const bf16_t* gp = zG + (size_t)(row0 + ai * 128 + m * 16) * ZGW + b * 1024 + col0;
#pragma unroll
                for (int bj = 0; bj < 2; ++bj) {
                    const u32x4 g0 = *(const u32x4*)(gp + bj * 128), g1 = *(const u32x4*)(gp + 1024 + bj * 128);
#pragma unroll
                    for (int e = 0; e < 4; ++e) {
                        const float rlo = bflo(g0[e]) * __builtin_amdgcn_rcpf(bflo(g1[e])), rhi = bfhi(g0[e]) * __builtin_amdgcn_rcpf(bfhi(g1[e]));
                        acc[ai][bj][m][e >> 1][(e & 1) * 2] *= rlo; acc[ai][bj][m][e >> 1][(e & 1) * 2 + 1] *= rhi;
                    }
                }
                __builtin_amdgcn_sched_barrier(0);
            }
    }
    __device__ __forceinline__ void operator()(const AccT& acc, const pg8::Unit& u, int wr, int wc, int fr, int fq) const {
        const int row0 = u.pm * 256 + wr * 64 + fr, col0 = u.pn * 256 + wc * 32 + 8 * fq;
#pragma unroll
        for (int ai = 0; ai < 2; ++ai)
#pragma unroll
            for (int m = 0; m < 4; ++m) {
                const size_t r = (size_t)(row0 + ai * 128 + m * 16);
                bf16_t* rowp = mb + r * 1024 + col0; const bf16_t* gp = zG + r * ZGW + 3072 + col0;
#pragma unroll
                for (int bj = 0; bj < 2; ++bj) {
                    const f32x4 v0 = acc[ai][bj][m][0], v1 = acc[ai][bj][m][1];
                    const u32x4 g = *(const u32x4*)(gp + bj * 128);
                    f32x4 o0, o1;
                    o0[0] = v0[0] * bflo(g[0]); o0[1] = v0[1] * bfhi(g[0]); o0[2] = v0[2] * bflo(g[1]); o0[3] = v0[3] * bfhi(g[1]);
                    o1[0] = v1[0] * bflo(g[2]); o1[1] = v1[1] * bfhi(g[2]); o1[2] = v1[2] * bflo(g[3]); o1[3] = v1[3] * bfhi(g[3]);
                    *(u32x4*)(rowp + bj * 128) = pack8(o0, o1);
                }
            }
    }
};

enum { M_BF16 = 0, M_WIN, M_F32, M_GLU, M_MERGE };
struct EpiUni {
    int mode; void* O; int ld; const bf16_t* zG; int goff; bf16_t* O2;
    __device__ __forceinline__ void mid(AccT& acc, const pg8::Unit& u, int t, int wr, int wc, int fr, int fq) const {
        if (mode == M_MERGE && (t == 12 || t == 16 || t == 28)) { EpiMergeF E; E.mb = (bf16_t*)O; E.zG = zG; E.rescale(acc, u, t == 12 ? 0 : (t == 16 ? 1 : 2), wr, wc, fr, fq); }
    }
    __device__ __forceinline__ void operator()(const AccT& acc, const pg8::Unit& u, int wr, int wc, int fr, int fq) const {
        if (mode == M_F32) { EpiF32 E; E.C = (float*)O; E.ld = ld; E(acc, u, wr, wc, fr, fq); }
        else if (mode == M_GLU) { EpiGlu E; E.O = (bf16_t*)O; E(acc, u, wr, wc, fr, fq); }
        else if (mode == M_MERGE) { EpiMergeF E; E.mb = (bf16_t*)O; E.zG = zG; E(acc, u, wr, wc, fr, fq); }
        else if (mode == M_WIN) { EpiWin E; E.zA = (bf16_t*)O; E.zG = O2; E(acc, u, wr, wc, fr, fq); }
        else { EpiBf16 E; E.O = (bf16_t*)O; E.ld = ld; E(acc, u, wr, wc, fr, fq); }
    }
};

struct ConvJob { const float* s; bf16_t* d; int N, ldd, nbase; bool glu, valid; };
constexpr int CONV_NJ = 12;
__device__ __forceinline__ int conv_total() {
    const int Ks[12] = {1024, 768, 1024, 768, 256, 768, 768, 1024, 1024, 3072, 64, 64};
    const int Ns[12] = {NIN, 1536, 1536, 1024, 1024, 1024, 1024, 1024, 6144, 1024, 64, 64};
    const int nbs[12] = {1, 1, 1, 1, 1, 1, 1, 1, 1, 1, 12, 12};
    int tot = 0;
#pragma unroll
    for (int j = 0; j < CONV_NJ; ++j) tot += (Ks[j] / 64) * (Ns[j] / 64) * nbs[j];
    return tot;
}
__device__ __forceinline__ ConvJob conv_decode(const Args& a, int l, int t, int nconv) {
    const int Ks[12] = {1024, 768, 1024, 768, 256, 768, 768, 1024, 1024, 3072, 64, 64};
    const int Ns[12] = {NIN, 1536, 1536, 1024, 1024, 1024, 1024, 1024, 6144, 1024, 64, 64};
    const int nbs[12] = {1, 1, 1, 1, 1, 1, 1, 1, 1, 1, 12, 12};
    const int srcs[12] = {I_WIN, I_SGLU, I_MEMWKV, I_PA, I_PB, I_PC, I_PX, I_WOUT, I_FUP, I_FDOWN, I_LWA, I_LWX};
    const size_t dsts[12] = {WS_WINT, WS_GLUT, WS_WKVT, WS_PAT, WS_PAT, WS_PAT, WS_PAT, WS_WOUTT, WS_UPT, WS_DOWNT, WS_WAT, WS_WXT};
    const int ldds[12] = {1024, 768, 1024, YCW, YCW, YCW, YCW, 1024, 1024, 3072, 64, 64};
    const int koffs[12] = {0, 0, 0, YC_A, YC_B, YC_C, YC_X, 0, 0, 0, 0, 0};
    ConvJob jb; jb.valid = t < nconv; jb.s = nullptr; jb.d = nullptr; jb.N = 64; jb.ldd = 64; jb.nbase = 0; jb.glu = false;
    if (!jb.valid) return jb;
    int st = 0, j = 0, K = 64, N = 64, nb = 1, si = 0, ldd = 64, koff = 0; size_t dz = 0;
    int acc = 0;
#pragma unroll
    for (int q = 0; q < CONV_NJ; ++q) { const int cnt = (Ks[q] / 64) * (Ns[q] / 64) * nbs[q]; if (t >= acc) { j = q; st = acc; K = Ks[q]; N = Ns[q]; nb = nbs[q]; si = srcs[q]; dz = dsts[q]; ldd = ldds[q]; koff = koffs[q]; } acc += cnt; }
    const int tile = t - st, tk = K / 64, tn = N / 64, per = tk * tn;
    const int bi = tile / per, tt = tile % per, kt = tt / tn, nt = tt % tn;
    jb.s = inp(a, si) + (size_t)l * K * N * nb + (size_t)bi * K * N + (size_t)(kt * 64) * N + nt * 64;
    jb.d = (bf16_t*)(wsp(a) + dz) + (size_t)bi * K * N + koff + kt * 64;
    jb.N = N; jb.ldd = ldd; jb.nbase = nt * 64; jb.glu = (j == 1);
    return jb;
}
__device__ void s5_param_tile(const Args& a, int l, int g, float* lds) {
    const int tid = tidx();
    float* zre = lds; float* zim = lds + 64;
    float* abar = (float*)(wsp(a) + WS_ABAR); float* abarl = (float*)(wsp(a) + WS_ABARL);
    if (tid < 64) {
        const int p = tid;
        const float dt = expf(inp(a, I_SLOGDT)[l * 48 + g]);
        const float lr = inp(a, I_SARE)[(l * 48 + g) * 64 + p], li = inp(a, I_SAIM)[(l * 48 + g) * 64 + p];
        const float mag = expf(lr * dt);
        const float abr = mag * cosf(li * dt), abi = mag * sinf(li * dt);
        const float den = lr * lr + li * li;
        zre[p] = ((abr - 1.0f) * lr + abi * li) / den;
        zim[p] = (abi * lr - (abr - 1.0f) * li) / den;
        abar[(g * 64 + p) * 2] = abr; abar[(g * 64 + p) * 2 + 1] = abi;
        float pr = abr, pi = abi;
        for (int i = 0; i < 7; ++i) { const float nr = pr * pr - pi * pi, ni = 2.0f * pr * pi; pr = nr; pi = ni; }
        abarl[(g * 64 + p) * 2] = pr; abarl[(g * 64 + p) * 2 + 1] = pi;
    }
    __syncthreads();
    bf16_t* bbt = (bf16_t*)(wsp(a) + WS_BBART) + (size_t)g * 128 * 16;
    bf16_t* cm = (bf16_t*)(wsp(a) + WS_CMAT) + (size_t)g * 16 * 128;
    for (int e = tid; e < 1024; e += 512) {
        const int p = e >> 4, h = e & 15;
        const float br = inp(a, I_SBRE)[((size_t)(l * 48 + g) * 64 + p) * 16 + h], bi = inp(a, I_SBIM)[((size_t)(l * 48 + g) * 64 + p) * 16 + h];
        bbt[p * 16 + h] = f2bf(zre[p] * br - zim[p] * bi);
        bbt[(64 + p) * 16 + h] = f2bf(zre[p] * bi + zim[p] * br);
    }
    for (int e = tid; e < 2048; e += 512) {
        const int h = e >> 7, k = e & 127;
        const float v = (k < 64) ? inp(a, I_SCRE)[((size_t)(l * 48 + g) * 16 + h) * 64 + k] : -inp(a, I_SCIM)[((size_t)(l * 48 + g) * 16 + h) * 64 + (k - 64)];
        cm[h * 128 + k] = f2bf(v);
    }
    __syncthreads();
}

__device__ __forceinline__ float wave_sum(float v) {
#pragma unroll
    for (int o = 32; o > 0; o >>= 1) v += __shfl_xor(v, o);
    return v;
}

__device__ void phase_convert(const Args& a, int l, float* lds) {
    const int nconv = conv_total();
    const int n_s5 = 48, n_mem = 64;
    const int total = nconv + n_s5 + n_mem;
    const int tid = tidx();
    for (int t0 = blockIdx.x; t0 < nconv; t0 += 4 * gridDim.x) {
        ConvJob jb[4]; float v[4][8];
#pragma unroll
        for (int q = 0; q < 4; ++q) {
            jb[q] = conv_decode(a, l, t0 + q * (int)gridDim.x, nconv);
            if (jb[q].valid) {
#pragma unroll
                for (int i = 0; i < 8; ++i) { const int idx = i * 512 + tid, r = idx >> 6, c = idx & 63; v[q][i] = jb[q].s[(size_t)r * jb[q].N + c]; }
            }
        }
#pragma unroll
        for (int q = 0; q < 4; ++q) {
            if (jb[q].valid) {
#pragma unroll
                for (int i = 0; i < 8; ++i) { const int idx = i * 512 + tid, r = idx >> 6, c = idx & 63; lds[q * 4160 + r * 65 + c] = v[q][i]; }
            }
        }
        __syncthreads();
#pragma unroll
        for (int q = 0; q < 4; ++q) {
            if (jb[q].valid) {
#pragma unroll
                for (int i = 0; i < 4; ++i) {
                    const int idx = i * 512 + tid, rn = idx >> 5, ck = (idx & 31) * 2;
                    int n = jb[q].nbase + rn;
                    if (jb[q].glu) { n = (n < 768) ? ((n >> 7) * 256 + (n & 127)) : (((n - 768) >> 7) * 256 + 128 + ((n - 768) & 127)); }
                    *(unsigned*)(jb[q].d + (size_t)n * jb[q].ldd + ck) = cvt_pk_bf16(lds[q * 4160 + ck * 65 + rn], lds[q * 4160 + (ck + 1) * 65 + rn]);
                }
            }
        }
        __syncthreads();
    }
    for (int t = nconv + blockIdx.x; t < total; t += gridDim.x) {
        if (t < nconv + n_s5) {

            s5_param_tile(a, l, t - nconv, lds);
        } else {
            const int row = (t - nconv - n_s5) * 8 + (tidx() >> 6), lane = tidx() & 63;
            const float* x = inp(a, I_MEM) + (size_t)row * 1024; const float* g = inp(a, I_GMEM) + l * 1024;
            f32x4 v[4]; float ss = 0.f;
#pragma unroll
            for (int i = 0; i < 4; ++i) { v[i] = *(const f32x4*)(x + i * 256 + lane * 4); ss += v[i][0] * v[i][0] + v[i][1] * v[i][1] + v[i][2] * v[i][2] + v[i][3] * v[i][3]; }
            ss = wave_sum(ss); const float sc = rsqrtf(ss * (1.0f / 1024.0f) + EPS);
            bf16_t* o = (bf16_t*)(wsp(a) + WS_MEMN) + (size_t)row * 1024;
#pragma unroll
            for (int i = 0; i < 4; ++i) { const f32x4 gg = *(const f32x4*)(g + i * 256 + lane * 4); u32x2 w; w.x = cvt_pk_bf16(v[i][0] * sc * gg[0], v[i][1] * sc * gg[1]); w.y = cvt_pk_bf16(v[i][2] * sc * gg[2], v[i][3] * sc * gg[3]); *(u32x2*)(o + i * 256 + lane * 4) = w; }
        }
    }
}

__device__ void phase_prenorm(const float* __restrict__ x, const float* __restrict__ g, bf16_t* __restrict__ hb) {
    const int lane = tidx() & 63, w = tidx() >> 6;
    for (int t = blockIdx.x; t < LSEQ / 8; t += gridDim.x) {
        const int row = t * 8 + w;
        const float* xr = x + (size_t)row * 1024;
        f32x4 v[4]; float ss = 0.f;
#pragma unroll
        for (int i = 0; i < 4; ++i) { v[i] = *(const f32x4*)(xr + i * 256 + lane * 4); ss += v[i][0] * v[i][0] + v[i][1] * v[i][1] + v[i][2] * v[i][2] + v[i][3] * v[i][3]; }
        ss = wave_sum(ss); const float sc = rsqrtf(ss * (1.0f / 1024.0f) + EPS);
        bf16_t* o = hb + (size_t)row * 1024;
#pragma unroll
        for (int i = 0; i < 4; ++i) { const f32x4 gg = *(const f32x4*)(g + i * 256 + lane * 4); u32x2 wv; wv.x = cvt_pk_bf16(v[i][0] * sc * gg[0], v[i][1] * sc * gg[1]); wv.y = cvt_pk_bf16(v[i][2] * sc * gg[2], v[i][3] * sc * gg[3]); *(u32x2*)(o + i * 256 + lane * 4) = wv; }
    }
}

template <bool WITH_H>
__device__ void phase_postnorm(const float* xin, const bf16_t* __restrict__ y, const float* __restrict__ gpost, float* xout,
                               const float* __restrict__ gpre, bf16_t* __restrict__ hb) {
    const int lane = tidx() & 63, w = tidx() >> 6;
    f32x4 gp[2][2], gq[2][2];
#pragma unroll
    for (int i = 0; i < 2; ++i)
#pragma unroll
        for (int h = 0; h < 2; ++h) { gp[i][h] = *(const f32x4*)(gpost + i * 512 + lane * 8 + h * 4); if (WITH_H) gq[i][h] = *(const f32x4*)(gpre + i * 512 + lane * 8 + h * 4); }
    for (int t = blockIdx.x; t < LSEQ / 32; t += gridDim.x) {
        const int row0 = t * 32 + w * 4;
        u32x4 yv[4][2]; f32x4 xv[4][2][2];
#pragma unroll
        for (int r = 0; r < 4; ++r)
#pragma unroll
            for (int i = 0; i < 2; ++i) {
                yv[r][i] = *(const u32x4*)(y + (size_t)(row0 + r) * 1024 + i * 512 + lane * 8);
                xv[r][i][0] = *(const f32x4*)(xin + (size_t)(row0 + r) * 1024 + i * 512 + lane * 8);
                xv[r][i][1] = *(const f32x4*)(xin + (size_t)(row0 + r) * 1024 + i * 512 + lane * 8 + 4);
            }
#pragma unroll
        for (int r = 0; r < 4; ++r) {
            float yf[2][8]; float ss = 0.f;
#pragma unroll
            for (int i = 0; i < 2; ++i)
#pragma unroll
                for (int e = 0; e < 4; ++e) { yf[i][2 * e] = bflo(yv[r][i][e]); yf[i][2 * e + 1] = bfhi(yv[r][i][e]); ss += yf[i][2 * e] * yf[i][2 * e] + yf[i][2 * e + 1] * yf[i][2 * e + 1]; }
            ss = wave_sum(ss); const float sc = rsqrtf(ss * (1.0f / 1024.0f) + EPS);
            float s2 = 0.f;
#pragma unroll
            for (int i = 0; i < 2; ++i)
#pragma unroll
                for (int h = 0; h < 2; ++h) {
#pragma unroll
                    for (int e = 0; e < 4; ++e) { const float v = xv[r][i][h][e] + yf[i][h * 4 + e] * sc * gp[i][h][e]; xv[r][i][h][e] = v; s2 += v * v; }
                    *(f32x4*)(xout + (size_t)(row0 + r) * 1024 + i * 512 + lane * 8 + h * 4) = xv[r][i][h];
                }
            if (WITH_H) {
                s2 = wave_sum(s2); const float sc2 = rsqrtf(s2 * (1.0f / 1024.0f) + EPS);
#pragma unroll
                for (int i = 0; i < 2; ++i) {
                    f32x4 o0, o1;
#pragma unroll
                    for (int e = 0; e < 4; ++e) { o0[e] = xv[r][i][0][e] * sc2 * gq[i][0][e]; o1[e] = xv[r][i][1][e] * sc2 * gq[i][1][e]; }
                    u32x4 wv; wv[0] = cvt_pk_bf16(o0[0], o0[1]); wv[1] = cvt_pk_bf16(o0[2], o0[3]); wv[2] = cvt_pk_bf16(o1[0], o1[1]); wv[3] = cvt_pk_bf16(o1[2], o1[3]);
                    *(u32x4*)(hb + (size_t)(row0 + r) * 1024 + i * 512 + lane * 8) = wv;
                }
            }
        }
    }
}

#define WSYNC() __syncthreads()
template <int PASS>
__device__ void s5_item(const Args& a, int l, int item, float* wl  ) {
    const int lane = tidx() & 63, fr = lane & 15, fq = lane >> 4;
    const int g = item % 48, chunk = item / 48;
    const bf16_t* zA = (const bf16_t*)(wsp(a) + WS_ZA);
    const bf16_t* bbt = (const bf16_t*)(wsp(a) + WS_BBART) + (size_t)g * 128 * 16;
    const bf16_t* cm = (const bf16_t*)(wsp(a) + WS_CMAT) + (size_t)g * 16 * 128;
    const float* abar = (const float*)(wsp(a) + WS_ABAR);
    float* s5c = (float*)(wsp(a) + WS_S5C);
    const bf16x8 zero8 = {0, 0, 0, 0, 0, 0, 0, 0};
    bf16x8 bB[8];
#pragma unroll
    for (int cb = 0; cb < 8; ++cb) bB[cb] = (fq < 2) ? *(const bf16x8*)(bbt + (cb * 16 + fr) * 16 + fq * 8) : zero8;
    bf16x8 bC[4];
    float dsk = 0.f;
    if (PASS == 2) {
#pragma unroll
        for (int ks = 0; ks < 4; ++ks) bC[ks] = *(const bf16x8*)(cm + fr * 128 + ks * 32 + fq * 8);
        dsk = inp(a, I_SD)[l * 768 + g * 16 + fr];
    }
    const float ar = abar[(g * 64 + lane) * 2], ai = abar[(g * 64 + lane) * 2 + 1];
    float xr = 0.f, xi = 0.f;
    if (PASS == 2) { xr = s5c[((size_t)(chunk * 48 + g) * 64 + lane) * 2]; xi = s5c[((size_t)(chunk * 48 + g) * 64 + lane) * 2 + 1]; }
    const int t0 = chunk * S5_LC;
    bf16x8 aUn[2];
#pragma unroll
    for (int rb = 0; rb < 2; ++rb) aUn[rb] = (fq < 2) ? *(const bf16x8*)(zA + (size_t)(t0 + rb * 16 + fr) * ZAW + OFF_US + g * 16 + fq * 8) : zero8;
    for (int sub = 0; sub < S5_LC / 32; ++sub) {
        const int ts = t0 + sub * 32;
        bf16x8 aUc[2]; aUc[0] = aUn[0]; aUc[1] = aUn[1];
        if (sub + 1 < S5_LC / 32) {
#pragma unroll
            for (int rb = 0; rb < 2; ++rb) aUn[rb] = (fq < 2) ? *(const bf16x8*)(zA + (size_t)(ts + 32 + rb * 16 + fr) * ZAW + OFF_US + g * 16 + fq * 8) : zero8;
        }
        bf16_t uq[2][4];
        if (PASS == 2) {
#pragma unroll
            for (int rb = 0; rb < 2; ++rb)
#pragma unroll
                for (int j = 0; j < 4; ++j) uq[rb][j] = zA[(size_t)(ts + rb * 16 + fq * 4 + j) * ZAW + OFF_US + g * 16 + fr];
        }
#pragma unroll
        for (int rb = 0; rb < 2; ++rb) {
            const bf16x8 aU = aUc[rb];
#pragma unroll
            for (int cb = 0; cb < 8; ++cb) {
                f32x4 c = {0.f, 0.f, 0.f, 0.f};
                c = __builtin_amdgcn_mfma_f32_16x16x32_bf16(aU, bB[cb], c, 0, 0, 0);
#pragma unroll
                for (int j = 0; j < 4; ++j) wl[(rb * 16 + fq * 4 + j) * 132 + cb * 16 + fr] = c[j];
            }
        }
        WSYNC();
#pragma unroll 8
        for (int t = 0; t < 32; ++t) {
            const float br = wl[t * 132 + lane], bi = wl[t * 132 + 64 + lane];
            const float nr = ar * xr - ai * xi + br, ni = ar * xi + ai * xr + bi;
            xr = nr; xi = ni;
            if (PASS == 2) { wl[t * 132 + lane] = xr; wl[t * 132 + 64 + lane] = xi; }
        }
        WSYNC();
        if (PASS == 2) {
#pragma unroll
            for (int rb = 0; rb < 2; ++rb) {
                f32x4 c = {0.f, 0.f, 0.f, 0.f};
#pragma unroll
                for (int ks = 0; ks < 4; ++ks) {
                    const float* xp = wl + (rb * 16 + fr) * 132 + ks * 32 + fq * 8;
                    const f32x4 x0 = *(const f32x4*)xp, x1 = *(const f32x4*)(xp + 4);
                    union { bf16x8 v; unsigned u[4]; } A;
                    A.u[0] = cvt_pk_bf16(x0[0], x0[1]); A.u[1] = cvt_pk_bf16(x0[2], x0[3]); A.u[2] = cvt_pk_bf16(x1[0], x1[1]); A.u[3] = cvt_pk_bf16(x1[2], x1[3]);
                    c = __builtin_amdgcn_mfma_f32_16x16x32_bf16(A.v, bC[ks], c, 0, 0, 0);
                }
                bf16_t* gy = (bf16_t*)(wsp(a) + WS_GY);
#pragma unroll
                for (int j = 0; j < 4; ++j) {
                    const int tok = ts + rb * 16 + fq * 4 + j;
                    const float uu = bf2f(uq[rb][j]);
                    gy[(size_t)tok * 768 + g * 16 + fr] = f2bf(gelu_tanh(c[j] + dsk * uu));
                }
            }
            WSYNC();
        }
    }
    if (PASS == 1) { s5c[((size_t)(chunk * 48 + g) * 64 + lane) * 2] = xr; s5c[((size_t)(chunk * 48 + g) * 64 + lane) * 2 + 1] = xi; }
}

template <int PASS>
__device__ void lru_item(const Args& a, int l, int item, unsigned char* wlb  ) {
    const int lane = tidx() & 63, fr = lane & 15, fq = lane >> 4;
    const int n = item % 12, chunk = item / 12;
    const int ch = n * 64 + lane;
    const bf16_t* zA = (const bf16_t*)(wsp(a) + WS_ZA);
    float* xcf = (float*)wlb;
    float* abuf = (float*)(wlb + 4096);
    bf16_t* xcb = (bf16_t*)(wlb + 8192);
    const bf16_t* waT = (const bf16_t*)(wsp(a) + WS_WAT) + n * 4096;
    const bf16_t* wxT = (const bf16_t*)(wsp(a) + WS_WXT) + n * 4096;
    bf16x8 bWa[4][2], bWx[4][2];
    float ba4[4], bx4[4], sp4[4];
#pragma unroll
    for (int cb = 0; cb < 4; ++cb) {
#pragma unroll
        for (int ks = 0; ks < 2; ++ks) { bWa[cb][ks] = *(const bf16x8*)(waT + (cb * 16 + fr) * 64 + ks * 32 + fq * 8); bWx[cb][ks] = *(const bf16x8*)(wxT + (cb * 16 + fr) * 64 + ks * 32 + fq * 8); }
        const int cc = l * 768 + n * 64 + cb * 16 + fr;
        ba4[cb] = inp(a, I_LBA)[cc]; bx4[cb] = inp(a, I_LBX)[cc];
        const float lam = inp(a, I_LLAM)[cc];
        sp4[cb] = (lam < -20.f) ? -lam : log1pf(__expf(-lam));
    }
    const float w0 = inp(a, I_LCW)[(l * 4 + 0) * 768 + ch], w1 = inp(a, I_LCW)[(l * 4 + 1) * 768 + ch], w2 = inp(a, I_LCW)[(l * 4 + 2) * 768 + ch], w3 = inp(a, I_LCW)[(l * 4 + 3) * 768 + ch];
    const float cbias = inp(a, I_LCB)[l * 768 + ch];
    const int t0 = chunk * LRU_LC;
    float xm3 = 0.f, xm2 = 0.f, xm1 = 0.f;
    if (t0 > 0) { xm3 = bf2f(zA[(size_t)(t0 - 3) * ZAW + OFF_XA + ch]); xm2 = bf2f(zA[(size_t)(t0 - 2) * ZAW + OFF_XA + ch]); xm1 = bf2f(zA[(size_t)(t0 - 1) * ZAW + OFF_XA + ch]); }
    float* lp = (float*)(wsp(a) + WS_LRUP); float* lh = (float*)(wsp(a) + WS_LRUH);
    float h = 0.f, P = 1.f;
    if (PASS == 2) h = lh[(size_t)chunk * 768 + ch];
    bf16_t* ya = (bf16_t*)(wsp(a) + WS_YCAT) + YC_A;
    bf16_t xq[16], gq[16];
#pragma unroll
    for (int t = 0; t < 16; ++t) xq[t] = zA[(size_t)(t0 + t) * ZAW + OFF_XA + ch];
    for (int sub = 0; sub < LRU_LC / 16; ++sub) {
        const int ts = t0 + sub * 16;
        if (PASS == 2) {
#pragma unroll
            for (int t = 0; t < 16; ++t) gq[t] = zA[(size_t)(ts + t) * ZAW + OFF_GA + ch];
        }
#pragma unroll
        for (int t = 0; t < 16; ++t) {
            const float xv = bf2f(xq[t]);
            const float xc = cbias + w0 * xm3 + w1 * xm2 + w2 * xm1 + w3 * xv;
            xm3 = xm2; xm2 = xm1; xm1 = xv;
            xcf[t * 64 + lane] = xc; xcb[t * 72 + lane] = f2bf(xc);
        }
        if (sub + 1 < LRU_LC / 16) {
#pragma unroll
            for (int t = 0; t < 16; ++t) xq[t] = zA[(size_t)(ts + 16 + t) * ZAW + OFF_XA + ch];
        }
        asm volatile("s_waitcnt lgkmcnt(0)" ::: "memory");
        bf16x8 aX[2];
#pragma unroll
        for (int ks = 0; ks < 2; ++ks) aX[ks] = *(const bf16x8*)(xcb + fr * 72 + ks * 32 + fq * 8);
#pragma unroll
        for (int cb = 0; cb < 4; ++cb) {
            f32x4 cA = {0.f, 0.f, 0.f, 0.f}, cX = {0.f, 0.f, 0.f, 0.f};
            cA = __builtin_amdgcn_mfma_f32_16x16x32_bf16(aX[0], bWa[cb][0], cA, 0, 0, 0);
            cA = __builtin_amdgcn_mfma_f32_16x16x32_bf16(aX[1], bWa[cb][1], cA, 0, 0, 0);
            cX = __builtin_amdgcn_mfma_f32_16x16x32_bf16(aX[0], bWx[cb][0], cX, 0, 0, 0);
            cX = __builtin_amdgcn_mfma_f32_16x16x32_bf16(aX[1], bWx[cb][1], cX, 0, 0, 0);
#pragma unroll
            for (int j = 0; j < 4; ++j) {
                const int tok = fq * 4 + j, cc = cb * 16 + fr;
                const float r = sigmoidf_(cA[j] + ba4[cb]), ig = sigmoidf_(cX[j] + bx4[cb]);
                const float la = -8.0f * r * sp4[cb];
                const float av = fexp(la);
                const float xcv = xcf[tok * 64 + cc];
                const float uv = __builtin_amdgcn_sqrtf(fmaxf(1.0f - av * av, 0.0f)) * (ig * xcv);
                abuf[tok * 64 + cc] = av; xcf[tok * 64 + cc] = uv;
            }
        }
        asm volatile("s_waitcnt lgkmcnt(0)" ::: "memory");
#pragma unroll
        for (int t = 0; t < 16; ++t) {
            const float av = abuf[t * 64 + lane], uv = xcf[t * 64 + lane];
            h = av * h + uv; P *= av;
            if (PASS == 2) ya[(size_t)(ts + t) * YCW + ch] = f2bf(h * bf2f(gq[t]));
        }
        asm volatile("s_waitcnt lgkmcnt(0)" ::: "memory");
    }
    if (PASS == 1) { lp[(size_t)chunk * 768 + ch] = P; lh[(size_t)chunk * 768 + ch] = h; }
}

__device__ void dil_attn_tile(const Args& a, int tile, unsigned char* lds) {
    const int tid = tidx(), w = tid >> 6, lane = tid & 63, fr = lane & 15, fq = lane >> 4;
    const int head = tile >> 7, blk = tile & 127;
    const int g = head >> 2;
    const int dil = (g == 0) ? 1 : (g == 1 ? 4 : 16);
    const int r = blk % dil, nb = blk / dil;
    const float slope = exp2f(-8.0f * (float)(head + 1) / 12.0f) * (float)dil;
    const bf16_t* zA = (const bf16_t*)(wsp(a) + WS_ZA);
    bf16_t* Ks = (bf16_t*)lds;
    bf16_t* Vt = (bf16_t*)(lds + 256 * 144);
    constexpr int KS = 72, VS = 264;
    const size_t tq = (size_t)(nb * 128 + w * 16 + fr) * dil + r;
    bf16x8 bQ[2];
#pragma unroll
    for (int ks = 0; ks < 2; ++ks) bQ[ks] = *(const bf16x8*)(zA + tq * ZAW + OFF_Q + head * 64 + ks * 32 + fq * 8);
    const bf16x8 zero8 = {0, 0, 0, 0, 0, 0, 0, 0};
#pragma unroll
    for (int i = 0; i < 4; ++i) {
        const int c = i * 512 + tid, key = c >> 3, part = c & 7;
        const int kidx = nb * 128 + key - 128;
        bf16x8 kv = zero8, vv = zero8;
        if (kidx >= 0) {
            const size_t tok = (size_t)kidx * dil + r;
            kv = *(const bf16x8*)(zA + tok * ZAW + OFF_K + head * 64 + part * 8);
            vv = *(const bf16x8*)(zA + tok * ZAW + OFF_V + head * 64 + part * 8);
        }
        *(bf16x8*)(Ks + key * KS + part * 8) = kv;
#pragma unroll
        for (int e = 0; e < 8; ++e) Vt[(part * 8 + e) * VS + key] = (bf16_t)vv[e];
    }
    __syncthreads();
    f32x4 S[9];
    float mx = -1e30f;
#pragma unroll
    for (int kb = 0; kb < 9; ++kb) {
        f32x4 c = {0.f, 0.f, 0.f, 0.f};
#pragma unroll
        for (int ks = 0; ks < 2; ++ks) {
            const bf16x8 aK = *(const bf16x8*)(Ks + (w * 16 + kb * 16 + fr) * KS + ks * 32 + fq * 8);
            c = __builtin_amdgcn_mfma_f32_16x16x32_bf16(aK, bQ[ks], c, 0, 0, 0);
        }
#pragma unroll
        for (int j = 0; j < 4; ++j) {
            const int ki = w * 16 + kb * 16 + fq * 4 + j;
            const int dist = fr + 128 - kb * 16 - fq * 4 - j;
            const bool valid = (dist >= 0) && (dist <= 128) && (nb * 128 + ki - 128 >= 0);
            const float s = valid ? (c[j] * 0.125f - slope * (float)dist) : -1e30f;
            c[j] = s; mx = fmaxf(mx, s);
        }
        S[kb] = c;
    }
    mx = fmaxf(mx, __shfl_xor(mx, 16)); mx = fmaxf(mx, __shfl_xor(mx, 32));
    float lsum = 0.f;
    unsigned pk[9][2];
#pragma unroll
    for (int kb = 0; kb < 9; ++kb) {
        float p[4];
#pragma unroll
        for (int j = 0; j < 4; ++j) { p[j] = __expf(S[kb][j] - mx); lsum += p[j]; }
        pk[kb][0] = cvt_pk_bf16(p[0], p[1]); pk[kb][1] = cvt_pk_bf16(p[2], p[3]);
    }
    lsum += __shfl_xor(lsum, 16); lsum += __shfl_xor(lsum, 32);
    f32x4 O[4];
#pragma unroll
    for (int db = 0; db < 4; ++db) O[db] = (f32x4){0.f, 0.f, 0.f, 0.f};
#pragma unroll
    for (int pp = 0; pp < 5; ++pp) {
        union { bf16x8 v; unsigned u[4]; } B;
        B.u[0] = pk[2 * pp][0]; B.u[1] = pk[2 * pp][1];
        if (pp < 4) { B.u[2] = pk[2 * pp + 1][0]; B.u[3] = pk[2 * pp + 1][1]; } else { B.u[2] = 0; B.u[3] = 0; }
#pragma unroll
        for (int db = 0; db < 4; ++db) {
            union { bf16x8 v; u32x2 h[2]; } A;
            A.h[0] = *(const u32x2*)(Vt + (db * 16 + fr) * VS + w * 16 + (2 * pp) * 16 + fq * 4);
            if (pp < 4) A.h[1] = *(const u32x2*)(Vt + (db * 16 + fr) * VS + w * 16 + (2 * pp + 1) * 16 + fq * 4); else A.h[1] = (u32x2){0u, 0u};
            O[db] = __builtin_amdgcn_mfma_f32_16x16x32_bf16(A.v, B.v, O[db], 0, 0, 0);
        }
    }
    const float inv = 1.0f / lsum;
    bf16_t* oatt = (bf16_t*)(wsp(a) + WS_OATT);
#pragma unroll
    for (int db = 0; db < 4; ++db) {
        u32x2 wv; wv.x = cvt_pk_bf16(O[db][0] * inv, O[db][1] * inv); wv.y = cvt_pk_bf16(O[db][2] * inv, O[db][3] * inv);
        *(u32x2*)(oatt + tq * 768 + head * 64 + db * 16 + fq * 4) = wv;
    }
    if (fq == 0) ((float*)(wsp(a) + WS_LSE))[tq * 12 + head] = mx + __logf(lsum);
    __syncthreads();
}

__device__ void cross_attn_tile(const Args& a, int b, int tile, unsigned char* lds) {
    const int tid = tidx(), w = tid >> 6, lane = tid & 63, fr = lane & 15, fq = lane >> 4;
    const int hx = tile >> 7, qb = tile & 127;
    const bf16_t* zA = (const bf16_t*)(wsp(a) + WS_ZA);
    const bf16_t* kvm = (const bf16_t*)(wsp(a) + WS_KVM) + (size_t)b * 256 * 1536;
    constexpr int KS = 200, VS = 136;
    bf16_t* Ks = (bf16_t*)lds;
    bf16_t* Vt = (bf16_t*)(lds + 51200);
    const size_t tq = (size_t)qb * 128 + w * 16 + fr;
    bf16x8 bQ[6];
#pragma unroll
    for (int ks = 0; ks < 6; ++ks) bQ[ks] = *(const bf16x8*)(zA + tq * ZAW + OFF_XQ + hx * 192 + ks * 32 + fq * 8);
    f32x4 O[12];
#pragma unroll
    for (int db = 0; db < 12; ++db) O[db] = (f32x4){0.f, 0.f, 0.f, 0.f};
    float mrun = -1e30f, lrun = 0.f;
    const float scale = 0.07216878364870322f;
#pragma unroll 1
    for (int hf = 0; hf < 2; ++hf) {
#pragma unroll 2
        for (int i = 0; i < 6; ++i) {
            const int c = i * 512 + tid, key = c / 24, part = c % 24;
            const bf16_t* src = kvm + (size_t)(hf * 128 + key) * 1536 + hx * 192 + part * 8;
            *(bf16x8*)(Ks + key * KS + part * 8) = *(const bf16x8*)(src);
            const bf16x8 vv = *(const bf16x8*)(src + 768);
#pragma unroll
            for (int e = 0; e < 8; ++e) Vt[(part * 8 + e) * VS + key] = (bf16_t)vv[e];
        }
        __syncthreads();
        f32x4 S[8];
        float mx = -1e30f;
#pragma unroll
        for (int kb = 0; kb < 8; ++kb) {
            f32x4 c = {0.f, 0.f, 0.f, 0.f};
#pragma unroll
            for (int ks = 0; ks < 6; ++ks) {
                const bf16x8 aK = *(const bf16x8*)(Ks + (kb * 16 + fr) * KS + ks * 32 + fq * 8);
                c = __builtin_amdgcn_mfma_f32_16x16x32_bf16(aK, bQ[ks], c, 0, 0, 0);
            }
#pragma unroll
            for (int j = 0; j < 4; ++j) { c[j] *= scale; mx = fmaxf(mx, c[j]); }
            S[kb] = c;
        }
        mx = fmaxf(mx, __shfl_xor(mx, 16)); mx = fmaxf(mx, __shfl_xor(mx, 32));
        const float mnew = fmaxf(mrun, mx);
        const float alpha = __expf(mrun - mnew);
        mrun = mnew;
        float lsum = 0.f;
        unsigned pk[8][2];
#pragma unroll
        for (int kb = 0; kb < 8; ++kb) {
            float p[4];
#pragma unroll
            for (int j = 0; j < 4; ++j) { p[j] = __expf(S[kb][j] - mnew); lsum += p[j]; }
            pk[kb][0] = cvt_pk_bf16(p[0], p[1]); pk[kb][1] = cvt_pk_bf16(p[2], p[3]);
        }
        lsum += __shfl_xor(lsum, 16); lsum += __shfl_xor(lsum, 32);
        lrun = lrun * alpha + lsum;
#pragma unroll
        for (int db = 0; db < 12; ++db) { O[db][0] *= alpha; O[db][1] *= alpha; O[db][2] *= alpha; O[db][3] *= alpha; }
#pragma unroll
        for (int pp = 0; pp < 4; ++pp) {
            union { bf16x8 v; unsigned u[4]; } B;
            B.u[0] = pk[2 * pp][0]; B.u[1] = pk[2 * pp][1]; B.u[2] = pk[2 * pp + 1][0]; B.u[3] = pk[2 * pp + 1][1];
#pragma unroll
            for (int db = 0; db < 12; ++db) {
                union { bf16x8 v; u32x2 h[2]; } A;
                A.h[0] = *(const u32x2*)(Vt + (db * 16 + fr) * VS + (2 * pp) * 16 + fq * 4);
                A.h[1] = *(const u32x2*)(Vt + (db * 16 + fr) * VS + (2 * pp + 1) * 16 + fq * 4);
                O[db] = __builtin_amdgcn_mfma_f32_16x16x32_bf16(A.v, B.v, O[db], 0, 0, 0);
            }
        }
        __syncthreads();
    }
    const float inv = 1.0f / lrun;
    bf16_t* yx = (bf16_t*)(wsp(a) + WS_YCAT) + YC_X;
#pragma unroll
    for (int db = 0; db < 12; ++db) {
        u32x2 wv; wv.x = cvt_pk_bf16(O[db][0] * inv, O[db][1] * inv); wv.y = cvt_pk_bf16(O[db][2] * inv, O[db][3] * inv);
        *(u32x2*)(yx + tq * YCW + hx * 192 + db * 16 + fq * 4) = wv;
    }
}

__device__ void combine_tile(const Args& a, int tile) {
    const int tid = tidx();
    const size_t tok = (size_t)tile * 16 + (tid >> 5);
    const int j = (tid >> 3) & 3, part = tid & 7;
    const float* lse = (const float*)(wsp(a) + WS_LSE) + tok * 12;
    const float l0 = lse[j], l1 = lse[4 + j], l2 = lse[8 + j];
    const float m = fmaxf(l0, fmaxf(l1, l2));
    float w0 = __expf(l0 - m), w1 = __expf(l1 - m), w2 = __expf(l2 - m);
    const float inv = 1.0f / (w0 + w1 + w2); w0 *= inv; w1 *= inv; w2 *= inv;
    const bf16_t* o = (const bf16_t*)(wsp(a) + WS_OATT) + tok * 768 + j * 64 + part * 8;
    const u32x4 a0 = *(const u32x4*)(o), a1 = *(const u32x4*)(o + 256), a2 = *(const u32x4*)(o + 512);
    u32x4 rr;
#pragma unroll
    for (int e = 0; e < 4; ++e) {
        const float lo = w0 * bflo(a0[e]) + w1 * bflo(a1[e]) + w2 * bflo(a2[e]);
        const float hi = w0 * bfhi(a0[e]) + w1 * bfhi(a1[e]) + w2 * bfhi(a2[e]);
        rr[e] = cvt_pk_bf16(lo, hi);
    }
    *(u32x4*)((bf16_t*)(wsp(a) + WS_YCAT) + tok * YCW + YC_B + j * 64 + part * 8) = rr;
}

constexpr int N_S5_TILES = S5_NCH * 48 / 8;
constexpr int N_LRU_TILES = LRU_NCH * 12 / 8;
constexpr int N_DIL_TILES = 12 * 128;
constexpr int N_X_TILES = 4 * 128;
constexpr int N_COMB_TILES = LSEQ / 16;

#ifndef MIXSEL
#define MIXSEL 15
#endif
__device__ void phase_mix1(const Args& a, int l, int b, unsigned char* lds) {
    const int w = tidx() >> 6;
    for (int t = blockIdx.x; t < N_S5_TILES; t += gridDim.x) s5_item<1>(a, l, t * 8 + w, (float*)(lds + w * 16896));
    asm volatile("" ::: "memory"); __builtin_amdgcn_sched_barrier(0);
    for (int t = blockIdx.x; t < N_LRU_TILES; t += gridDim.x) lru_item<1>(a, l, t * 8 + w, lds + w * 16896);
}
__device__ void phase_carry(const Args& a);
__device__ void phase_mixB(const Args& a, int l, int b, unsigned char* lds) {
    if (blockIdx.x < 8) {
        phase_carry(a);
        for (int t = N_X_TILES - 16 + (int)blockIdx.x; t < N_X_TILES; t += 8) cross_attn_tile(a, b, t, lds);
        return;
    }
    const int nb = gridDim.x - 8, bi = blockIdx.x - 8;
    for (int t = bi; t < N_X_TILES - 16; t += nb) cross_attn_tile(a, b, t, lds);
    asm volatile("" ::: "memory"); __builtin_amdgcn_sched_barrier(0);
    for (int t = bi; t < N_DIL_TILES; t += nb) dil_attn_tile(a, t, lds);
}
__device__ void phase_mix2(const Args& a, int l, unsigned char* lds) {
    const int w = tidx() >> 6;
    DM(4) for (int t = blockIdx.x; t < N_S5_TILES; t += gridDim.x) s5_item<2>(a, l, t * 8 + w, (float*)(lds + w * 16896));
    DM(5) for (int t = blockIdx.x; t < N_LRU_TILES; t += gridDim.x) lru_item<2>(a, l, t * 8 + w, lds + w * 16896);
    DM(6) for (int t = blockIdx.x; t < N_COMB_TILES; t += gridDim.x) combine_tile(a, t);
}

__device__ void phase_carry(const Args& a) {
    const int gt = blockIdx.x * 512 + tidx();
    if (gt < 3072) {
        float* s5c = (float*)(wsp(a) + WS_S5C);
        const float* abarl = (const float*)(wsp(a) + WS_ABARL);
        const float ar = abarl[gt * 2], ai = abarl[gt * 2 + 1];
        float xr = 0.f, xi = 0.f;
#pragma unroll 8
        for (int c = 0; c < S5_NCH; ++c) {
            float* p = s5c + ((size_t)c * 3072 + gt) * 2;
            const float er = p[0], ei = p[1];
            p[0] = xr; p[1] = xi;
            const float nr = ar * xr - ai * xi + er, ni = ar * xi + ai * xr + ei;
            xr = nr; xi = ni;
        }
    } else if (gt < 3072 + 768) {
        const int ch = gt - 3072;
        float* lp = (float*)(wsp(a) + WS_LRUP); float* lh = (float*)(wsp(a) + WS_LRUH);
        float h = 0.f;
#pragma unroll 8
        for (int c = 0; c < LRU_NCH; ++c) {
            const float P = lp[(size_t)c * 768 + ch], H = lh[(size_t)c * 768 + ch];
            lh[(size_t)c * 768 + ch] = h;
            h = P * h + H;
        }
    }
}

__device__ void phase_ffn_act(const Args& a, int l) {
    const bf16_t* up = (const bf16_t*)(wsp(a) + WS_UP);
    bf16_t* act = (bf16_t*)(wsp(a) + WS_ACT);
    const int total = (DFF / 8) * (LSEQ / 16);
    for (int it = blockIdx.x * 512 + tidx(); it < total; it += gridDim.x * 512) {
        const int cg8 = it % (DFF / 8), run = it / (DFF / 8);
        const int c0 = cg8 * 8, t0 = run * 16;
        float w0[8], w1[8], w2[8], cb[8];
#pragma unroll
        for (int e = 0; e < 8; ++e) { w0[e] = inp(a, I_FCW)[(l * 3 + 0) * DFF + c0 + e]; w1[e] = inp(a, I_FCW)[(l * 3 + 1) * DFF + c0 + e]; w2[e] = inp(a, I_FCW)[(l * 3 + 2) * DFF + c0 + e]; cb[e] = inp(a, I_FCB)[l * DFF + c0 + e]; }
        u32x4 g2 = {0u, 0u, 0u, 0u}, g1 = {0u, 0u, 0u, 0u};
        if (t0 > 0) { g2 = *(const u32x4*)(up + (size_t)(t0 - 2) * 6144 + DFF + c0); g1 = *(const u32x4*)(up + (size_t)(t0 - 1) * 6144 + DFF + c0); }
        u32x4 gq[4], vq[4], gn[4], vn[4];
#pragma unroll
        for (int q = 0; q < 4; ++q) { gq[q] = *(const u32x4*)(up + (size_t)(t0 + q) * 6144 + DFF + c0); vq[q] = *(const u32x4*)(up + (size_t)(t0 + q) * 6144 + c0); }
#pragma unroll
        for (int tb = 0; tb < 16; tb += 4) {
            if (tb + 4 < 16) {
#pragma unroll
                for (int q = 0; q < 4; ++q) { gn[q] = *(const u32x4*)(up + (size_t)(t0 + tb + 4 + q) * 6144 + DFF + c0); vn[q] = *(const u32x4*)(up + (size_t)(t0 + tb + 4 + q) * 6144 + c0); }
            }
#pragma unroll
            for (int q = 0; q < 4; ++q) {
                const u32x4 g0 = gq[q], vv = vq[q];
                u32x4 rr;
#pragma unroll
                for (int e = 0; e < 4; ++e) {
                    const float glo = cb[2 * e] + w0[2 * e] * bflo(g2[e]) + w1[2 * e] * bflo(g1[e]) + w2[2 * e] * bflo(g0[e]);
                    const float ghi = cb[2 * e + 1] + w0[2 * e + 1] * bfhi(g2[e]) + w1[2 * e + 1] * bfhi(g1[e]) + w2[2 * e + 1] * bfhi(g0[e]);
                    rr[e] = cvt_pk_bf16(bflo(vv[e]) * gelu_tanh(glo), bfhi(vv[e]) * gelu_tanh(ghi));
                }
                *(u32x4*)(act + (size_t)(t0 + tb + q) * DFF + c0) = rr;
                g2 = g1; g1 = g0;
            }
#pragma unroll
            for (int q = 0; q < 4; ++q) { gq[q] = gn[q]; vq[q] = vn[q]; }
        }
    }
}


#define XB_TMO      128
#define XB_XCNT(j)  (256  + 64 * (j))
#define XB_XSUB(j)  (1280 + 64 * (j))
#define XB_XGEN(j)  (2304 + 64 * (j))
#define XB_TOP      3328
#define XB_TOPGEN   3392
#define XCD_BAR_WORDS 3456
#define XB_SPIN_CAP (1u << 18)
#define LAS __attribute__((address_space(3)))
__device__ __forceinline__ unsigned xb_ld(unsigned* p)              { return __hip_atomic_load(p, __ATOMIC_RELAXED, __HIP_MEMORY_SCOPE_AGENT); }
__device__ __forceinline__ unsigned xb_add(unsigned* p, unsigned v) { return __hip_atomic_fetch_add(p, v, __ATOMIC_RELAXED, __HIP_MEMORY_SCOPE_AGENT); }
__device__ __forceinline__ unsigned xb_xcc_id() { return (unsigned)__builtin_amdgcn_s_getreg((3 << 11) | 20) & 0xFu; }
#define XB_SPIN(cond, bar) do { unsigned _sp = 0; while (cond) { __builtin_amdgcn_s_sleep(1); \
    if ((++_sp & 255u) == 0u) { if (xb_ld(&(bar)[XB_TMO])) break; if (_sp > XB_SPIN_CAP) { atomicAdd(&(bar)[XB_TMO], 1u); break; } } } } while (0)
struct XcdBarrier { unsigned* bar; unsigned x; volatile LAS unsigned* st; };
__device__ __forceinline__ XcdBarrier xcd_barrier_post(unsigned* bar, volatile LAS unsigned* st) {
    XcdBarrier b; b.bar = bar; b.x = xb_xcc_id(); b.st = st;
    if (threadIdx.x == 0) (void)xb_add(&bar[XB_XCNT(b.x)], 1u);
    return b;
}
__device__ __forceinline__ void xcd_barrier_complete(unsigned* bar, unsigned x, unsigned& nloc, unsigned& nx) {
    const unsigned G = gridDim.x * gridDim.y * gridDim.z;
    unsigned sum, cnt, mine, sp = 0u;
    for (;;) {
        sum = 0u; cnt = 0u; mine = 0u;
#pragma unroll
        for (unsigned j = 0; j < 16; ++j) { const unsigned c = xb_ld(&bar[XB_XCNT(j)]); sum += c; cnt += (c > 0u) ? 1u : 0u; mine = (j == x) ? c : mine; }
        if (sum == G) break;
        __builtin_amdgcn_s_sleep(1);
        if ((++sp & 255u) == 0u) { if (xb_ld(&bar[XB_TMO])) break; if (sp > XB_SPIN_CAP) { atomicAdd(&bar[XB_TMO], 1u); break; } }
    }
    nloc = mine > 0u ? mine : 1u; nx = cnt > 0u ? cnt : 1u;
}
__device__ __forceinline__ void xcd_barrier(const XcdBarrier& b) {
    asm volatile("s_waitcnt vmcnt(0)" ::: "memory");
    __syncthreads();
    if (threadIdx.x == 0) {
        unsigned* bar = b.bar;
        __builtin_amdgcn_s_waitcnt(0);
        unsigned nloc = b.st[0], nx = b.st[1];
        if (nloc == 0u) { xcd_barrier_complete(bar, b.x, nloc, nx); b.st[0] = nloc; b.st[1] = nx; }
        const unsigned old = xb_add(&bar[XB_XSUB(b.x)], 1u);
        const unsigned gen = old / nloc;
        if (old + 1u == (gen + 1u) * nloc) {
            __builtin_amdgcn_fence(__ATOMIC_RELEASE, "agent");
            asm volatile("s_waitcnt vmcnt(0)" ::: "memory");
            const unsigned og = xb_add(&bar[XB_TOP], 1u);
            const unsigned tg = og / nx;
            if (og + 1u == (tg + 1u) * nx) xb_add(&bar[XB_TOPGEN], 1u);
            else XB_SPIN(xb_ld(&bar[XB_TOPGEN]) == tg, bar);
            __builtin_amdgcn_fence(__ATOMIC_ACQUIRE, "agent");
            xb_add(&bar[XB_XGEN(b.x)], 1u);
            asm volatile("s_waitcnt vmcnt(0)" ::: "memory");
        } else {
            XB_SPIN(xb_ld(&bar[XB_XGEN(b.x)]) == gen, bar);
            __builtin_amdgcn_fence(__ATOMIC_ACQUIRE, "agent");
            asm volatile("s_waitcnt vmcnt(0)" ::: "memory");
        }
    }
    __syncthreads();
}

constexpr int PH_PER_BATCH = 16, PH_PER_LAYER = 2 + 2 * PH_PER_BATCH, PH_TOTAL = 2 * PH_PER_LAYER;


__global__ void __launch_bounds__(512, 2) mega_fwd(Args a) {
    extern __shared__ __attribute__((aligned(16))) unsigned char shm[];
    cg::grid_group grid = cg::this_grid();
    if (a.ph_lo < 0) grid.sync();
    if (threadIdx.x < 4) ((volatile LAS unsigned*)(shm + 135168))[threadIdx.x] = 0u;
    __syncthreads();
    XcdBarrier xbar = xcd_barrier_post((unsigned*)(GAS unsigned*)(a.ws + WS_BAR), (volatile LAS unsigned*)(shm + 135168));
    bool redo = false;
    for (int ph = a.ph_lo; ph < a.ph_hi; ++ph) {
        unsigned char* ws = wsp(a);
        const int l = ph / PH_PER_LAYER, r = ph % PH_PER_LAYER;
        const int b = (r >= 2) ? (r - 2) / PH_PER_BATCH : 0, s = (r >= 2) ? (r - 2) % PH_PER_BATCH : (r == 0 ? 100 : 101);
        if ((s >= 7 && s <= 9) || s == 101 || (s == 0 && b == 1)) continue;
        const size_t boff = (size_t)b * LSEQ * 1024;
        pg8::Gemm g; g.A = nullptr; g.Bt = nullptr; g.M = LSEQ; g.N = 1024; g.K = 1024;
        EpiUni E; E.mode = -1; E.O = nullptr; E.ld = 1024; E.zG = (const bf16_t*)(ws + WS_ZG); E.goff = 0; E.O2 = nullptr;
        switch (s) {
        case 1: g.A = (const bf16_t*)(ws + WS_HB); g.Bt = (const bf16_t*)(ws + WS_WINT); g.N = NIN; g.K = 1024; E.mode = M_WIN; E.O = ws + WS_ZA; E.O2 = (bf16_t*)(ws + WS_ZG); break;
        case 5: g.A = (const bf16_t*)(ws + WS_GY); g.Bt = (const bf16_t*)(ws + WS_GLUT); g.N = 1536; g.K = 768; E.mode = M_GLU; E.O = (bf16_t*)(ws + WS_YCAT) + YC_C; break;
        case 6: g.A = (const bf16_t*)(ws + WS_YCAT); g.Bt = (const bf16_t*)(ws + WS_PAT); g.K = YCW; E.mode = M_MERGE; E.O = ws + WS_MB; break;
        case 10: g.A = (const bf16_t*)(ws + WS_MB); g.Bt = (const bf16_t*)(ws + WS_WOUTT); g.K = 1024; E.mode = M_BF16; E.O = ws + WS_YOUT1; E.ld = 1024; break;
        case 12: g.A = (const bf16_t*)(ws + WS_HB); g.Bt = (const bf16_t*)(ws + WS_UPT); g.N = 6144; g.K = 1024; E.mode = M_BF16; E.O = ws + WS_UP; E.ld = 6144; break;
        case 14: g.A = (const bf16_t*)(ws + WS_ACT); g.Bt = (const bf16_t*)(ws + WS_DOWNT); g.K = 3072; E.mode = M_BF16; E.O = ws + WS_YOUT2; E.ld = 1024; break;
        default: break;
        }
        const int sidx = (s >= 100) ? s - 84 : s;
        const int reps = ((DUPMASK >> sidx) & 1) ? 2 : 1;
        for (int rep = 0; rep < reps; ++rep) {
        if (rep > 0) xcd_barrier(xbar);
        if (E.mode >= 0) {
            const int ngemm = (s == 1 && b == 0) ? 2 : 1;
            for (int gi = 0; gi < ngemm; ++gi) {
                pg8::StaticOrder S;
                if (gi == 0) S.init(g.M, g.N, (int)gridDim.x, (int)blockIdx.x);
                else {
                    g.A = (const bf16_t*)(ws + WS_MEMN); g.Bt = (const bf16_t*)(ws + WS_WKVT); g.M = 512; g.N = 1536; g.K = 1024;
                    E.mode = M_BF16; E.O = ws + WS_KVM; E.ld = 1536;
                    const int c2 = (int)blockIdx.x - 64;
                    S.init(512, 1536, 12, (c2 >= 0 && c2 < 12) ? c2 : (1 << 24));
                }
                if (PH_ON(1)) pg8::gemm_phase<EpiUni>((PG8_LAS unsigned char*)shm, g, S, E);
            }
        }
        if (E.mode < 0 || s == 0) {
            const float* xin = (l == 0 ? inp(a, I_X) : (const float*)outp(a)) + boff;
            float* xout = outp(a) + boff;
            if (s == 100) { if (PH_ON(100)) phase_convert(a, l, (float*)shm); }
            else if (s == 0) { if (PH_ON(0)) phase_prenorm(xin, inp(a, I_GMIXPRE) + l * 1024, (bf16_t*)(ws + WS_HB)); }
            else if (s == 2) { if (PH_ON(2)) phase_mix1(a, l, b, shm); }
            else if (s == 3) { if (PH_ON(3)) phase_mixB(a, l, b, shm); }
            else if (s == 4) { if (PH_ON(4)) phase_mix2(a, l, shm); }
            else if (s == 11) { if (PH_ON(11)) phase_postnorm<true>(xin, (const bf16_t*)(ws + WS_YOUT1), inp(a, I_GMIXPOST) + l * 1024, xout, inp(a, I_GMLPPRE) + l * 1024, (bf16_t*)(ws + WS_HB)); }
            else if (s == 13) { if (PH_ON(13)) phase_ffn_act(a, l); }
            else if (s == 15) {
                if (PH_ON(15)) phase_postnorm<false>(xout, (const bf16_t*)(ws + WS_YOUT2), inp(a, I_GMLPPOST) + l * 1024, xout, nullptr, nullptr);
                if (b == 0) {
                    const float* xin1 = (l == 0 ? inp(a, I_X) : (const float*)outp(a)) + (size_t)LSEQ * 1024;
                    phase_prenorm(xin1, inp(a, I_GMIXPRE) + l * 1024, (bf16_t*)(ws + WS_HB));
                }
            }
        }
        }
        if (ph + 1 < a.ph_hi) xcd_barrier(xbar);
#ifdef DUPMERGE
        if (s == 6 && !redo) { redo = true; ph -= 1; } else if (s == 10) redo = false;
#endif
    }
}

extern "C" void kernel_launch(void* const* d_in, const int* in_sizes, int n_in, void* d_out, int out_size, void* d_ws, size_t ws_size, hipStream_t stream) {
    static int grid = 0;
    if (grid == 0) {
        if (n_in != 34 || ws_size < WS_END) { fprintf(stderr, "kernel_launch: unexpected n_in %d or ws_size %zu (< %zu)\n", n_in, ws_size, (size_t)WS_END); grid = -1; return; }
        int dev = 0, cus = 0, per_cu = 0;
        hipGetDevice(&dev);
        hipDeviceGetAttribute(&cus, hipDeviceAttributeMultiprocessorCount, dev);
        hipFuncSetAttribute((const void*)mega_fwd, hipFuncAttributeMaxDynamicSharedMemorySize, LDS_BYTES);
        hipOccupancyMaxActiveBlocksPerMultiprocessor(&per_cu, (const void*)mega_fwd, 512, LDS_BYTES);
        if (per_cu < 1) per_cu = 1;
        grid = cus * per_cu;
        (void)hipGetLastError();
    }
    if (grid < 0) return;
    Args a{};
    for (int i = 0; i < 34; ++i) a.in[i] = (const float*)d_in[i];
    a.out = (float*)d_out; a.ws = (unsigned char*)d_ws;
    (void)hipMemsetAsync((unsigned char*)d_ws + WS_BAR, 0, 16384, stream);
#if MK_SINGLE
    a.ph_lo = 0; a.ph_hi = PH_TOTAL;
    void* args[] = {&a};
    hipError_t e = hipLaunchCooperativeKernel((const void*)mega_fwd, dim3(grid), dim3(512), args, LDS_BYTES, stream);
    if (e != hipSuccess) fprintf(stderr, "cooperative launch failed: %s (grid %d)\n", hipGetErrorString(e), grid);
#else
    for (int ph = 0; ph < PH_TOTAL; ++ph) {
        a.ph_lo = ph; a.ph_hi = ph + 1;
        hipLaunchKernelGGL(mega_fwd, dim3(grid), dim3(512), LDS_BYTES, stream, a);
    }
#endif
}
```

```cpp
#include <hip/hip_runtime.h>
#include <hip/hip_cooperative_groups.h>
#include <cstdio>
namespace cg = cooperative_groups;

#ifndef ONLY_S
#define ONLY_S -1
#endif
#ifndef PHMASK
#define PHMASK 0xFFFFF
#endif
#define PH_ON(k) ((ONLY_S < 0 || ONLY_S == (k)) && ((PHMASK >> ((k) >= 100 ? (k) - 84 : (k))) & 1))
#ifndef DUPMASK
#define DUPMASK 0
#endif
#ifndef DUPMIX
#define DUPMIX 0
#endif
#define DM(k) for (int _rp = 0; _rp < 1 + ((DUPMIX >> (k)) & 1); ++_rp)
#ifndef MK_SINGLE
#define MK_SINGLE 1
#endif

constexpr int LSEQ = 16384, DM = 1024, NBATCH = 2, NIN = 9472, MEMLEN = 256;
constexpr int ZAW = 5376, ZGW = 4160;
constexpr int OFF_XA = 0, OFF_GA = 768, OFF_Q = 1536, OFF_K = 2304, OFF_V = 3072, OFF_US = 3840, OFF_XQ = 4608;
constexpr int DFF = 3072;
constexpr int S5_LC = 128, S5_NCH = LSEQ / S5_LC;
constexpr int LRU_LC = 128, LRU_NCH = LSEQ / LRU_LC;
constexpr float EPS = 1e-6f;
constexpr int LDS_BYTES = 135168 + 16;

typedef unsigned short bf16_t;
typedef short bf16x8 __attribute__((ext_vector_type(8)));
typedef float f32x4 __attribute__((ext_vector_type(4)));
typedef unsigned u32x4 __attribute__((ext_vector_type(4)));
typedef unsigned u32x2 __attribute__((ext_vector_type(2)));

__device__ __forceinline__ unsigned cvt_pk_bf16(float lo, float hi) { unsigned r; asm volatile("v_cvt_pk_bf16_f32 %0, %1, %2" : "=v"(r) : "v"(lo), "v"(hi)); return r; }
__device__ __forceinline__ bf16_t f2bf(float f) { unsigned u = __float_as_uint(f); u += 0x7FFFu + ((u >> 16) & 1u); return (bf16_t)(u >> 16); }
__device__ __forceinline__ float bf2f(bf16_t b) { return __uint_as_float(((unsigned)b) << 16); }
__device__ __forceinline__ float bflo(unsigned w) { return __uint_as_float(w << 16); }
__device__ __forceinline__ float bfhi(unsigned w) { return __uint_as_float(w & 0xffff0000u); }
__device__ __forceinline__ float fexp(float x) { return __builtin_amdgcn_exp2f(x * 1.4426950408889634f); }
__device__ __forceinline__ float sigmoidf_(float x) { return __builtin_amdgcn_rcpf(1.0f + fexp(-x)); }
__device__ __forceinline__ float gelu_tanh(float x) { const float u = -2.3022081302f * (x + 0.044715f * x * x * x); return x * __builtin_amdgcn_rcpf(1.0f + __builtin_amdgcn_exp2f(u)); }

struct Args {
    const float* in[34];
    float* out;
    unsigned char* ws;
    int ph_lo, ph_hi;
};
enum { I_X = 0, I_MEM, I_GMIXPRE, I_GMIXPOST, I_GMEM, I_GMLPPRE, I_GMLPPOST, I_WIN, I_LCW, I_LCB, I_LWA, I_LBA, I_LWX, I_LBX, I_LLAM,
       I_SARE, I_SAIM, I_SLOGDT, I_SBRE, I_SBIM, I_SCRE, I_SCIM, I_SD, I_SGLU, I_MEMWKV, I_PA, I_PB, I_PC, I_PX, I_WOUT, I_FUP, I_FCW, I_FCB, I_FDOWN };

__device__ __forceinline__ int opq_s(int v) { asm volatile("" : "+s"(v)); return v; }
__device__ __forceinline__ int tidx() { int v = (int)threadIdx.x; asm volatile("" : "+v"(v)); return v; }
#define GAS __attribute__((address_space(1)))
__device__ __forceinline__ size_t opq0() { size_t z = 0; asm volatile("" : "+s"(z)); return z; }
__device__ __forceinline__ unsigned char* wsp(const Args& a) { return a.ws + opq0(); }
__device__ __forceinline__ float* outp(const Args& a) { return a.out + opq0(); }
__device__ __forceinline__ const float* inp(const Args& a, int k) { return a.in[k] + opq0(); }
constexpr size_t al256(size_t x) { return (x + 255) & ~(size_t)255; }
constexpr size_t WS_WINT = 0;
constexpr size_t WS_GLUT = WS_WINT + (size_t)NIN * 1024 * 2;
constexpr size_t WS_WKVT = WS_GLUT + (size_t)1536 * 768 * 2;
constexpr size_t WS_PAT = WS_WKVT + (size_t)1536 * 1024 * 2;
constexpr size_t WS_PBT = WS_PAT + (size_t)1024 * 768 * 2;
constexpr size_t WS_PCT = WS_PBT + (size_t)1024 * 256 * 2;
constexpr size_t WS_PXT = WS_PCT + (size_t)1024 * 768 * 2;
constexpr size_t WS_WOUTT = WS_PXT + (size_t)1024 * 768 * 2;
constexpr size_t WS_UPT = WS_WOUTT + (size_t)1024 * 1024 * 2;
constexpr size_t WS_DOWNT = WS_UPT + (size_t)6144 * 1024 * 2;
constexpr size_t WS_WAT = WS_DOWNT + (size_t)1024 * 3072 * 2;
constexpr size_t WS_WXT = WS_WAT + (size_t)12 * 4096 * 2;
constexpr size_t WS_ABAR = WS_WXT + (size_t)12 * 4096 * 2;
constexpr size_t WS_ABARL = WS_ABAR + (size_t)48 * 64 * 2 * 4;
constexpr size_t WS_BBART = WS_ABARL + (size_t)48 * 64 * 2 * 4;
constexpr size_t WS_CMAT = WS_BBART + (size_t)48 * 128 * 16 * 2;
constexpr size_t WS_MEMN = WS_CMAT + (size_t)48 * 16 * 128 * 2;
constexpr size_t WS_KVM = WS_MEMN + (size_t)512 * 1024 * 2;
constexpr size_t WS_S5C = WS_KVM + (size_t)512 * 1536 * 2;
constexpr size_t WS_LRUP = WS_S5C + (size_t)S5_NCH * 48 * 64 * 2 * 4;
constexpr size_t WS_LRUH = WS_LRUP + (size_t)LRU_NCH * 768 * 4;
constexpr size_t WS_HB = al256(WS_LRUH + (size_t)LRU_NCH * 768 * 4);
constexpr size_t WS_Z = WS_HB + (size_t)LSEQ * 1024 * 2;
constexpr size_t WS_ZA = WS_Z;
constexpr size_t WS_ZG = WS_ZA + (size_t)LSEQ * ZAW * 2;
constexpr size_t WS_UP = WS_Z;
constexpr size_t WS_ACT = WS_UP + (size_t)LSEQ * 6144 * 2;
constexpr size_t WS_MB = WS_ZA;
constexpr size_t WS_YOUT1 = WS_MB + (size_t)LSEQ * 1024 * 2;
constexpr size_t WS_Y = WS_ZG + (size_t)LSEQ * ZGW * 2;
constexpr size_t WS_OATT = WS_HB;
constexpr size_t WS_LSE = WS_Y;
constexpr size_t WS_GY = WS_LSE + (size_t)LSEQ * 12 * 4;
constexpr size_t WS_YCAT = WS_GY + (size_t)LSEQ * 768 * 2;
constexpr int YCW = 2560, YC_A = 0, YC_B = 768, YC_C = 1024, YC_X = 1792;
constexpr size_t WS_YOUT2 = WS_Y;
constexpr size_t WS_BAR = WS_YCAT + (size_t)LSEQ * YCW * 2;
constexpr size_t WS_END = WS_BAR + 16384;
static_assert(WS_ACT + (size_t)LSEQ * 3072 * 2 <= WS_Y, "up/act alias overflow");
static_assert(WS_YOUT1 + (size_t)LSEQ * 1024 * 4 <= WS_ZG, "mb/yout alias overflow");
static_assert(WS_YOUT2 + (size_t)LSEQ * 1024 * 4 <= WS_END, "yout2 alias overflow");
static_assert(WS_END <= (size_t)512 * 1024 * 1024, "workspace too large");

namespace pg8 {
#define PG8_LAS __attribute__((address_space(3)))
constexpr int BM = 256, BK = 64, HALF = 128, HTB = HALF * BK * 2, STAGE_BYTES = 8 * HTB, NXCD = 8, WGM = 4;
__host__ __device__ __forceinline__ int lds_byte(int r, int c) { const int st = (r >> 4) * 2 + (c >> 5), rr = r & 15, cc = c & 31, ob = rr * 64 + cc * 2; return st * 1024 + (ob ^ (((ob >> 9) & 1) << 5)); }
__host__ __device__ __forceinline__ void stage_rc(int b, int& R, int& C) { const int st = b / 1024, sb = b % 1024, swz = sb ^ (((sb >> 9) & 1) << 5); R = (st >> 1) * 16 + swz / 64; C = (st & 1) * 32 + (swz % 64) / 2; }
__host__ __device__ __forceinline__ int perm32(int rho) { const int n = rho >> 4, i = rho & 15; return 8 * (i >> 2) + 4 * n + (i & 3); }
struct Unit { int pm, pn; };
struct Gemm { const bf16_t* A; const bf16_t* Bt; int M, N, K; };
struct StaticOrder {
    int nM, nN, nwg, G, c;
    __device__ void init(int M, int N, int G_, int c_) { nM = M / BM; nN = N / BM; nwg = nM * nN; G = G_; c = c_; }
    __device__ bool next(int i, Unit& u) const {
        const long L = (long)i * G + c; if (L >= nwg) return false;
        int wgid = (int)L; { const int q = nwg / NXCD, r = nwg % NXCD, xcd = wgid % NXCD, off = wgid / NXCD; wgid = (xcd < r ? xcd * (q + 1) : r * (q + 1) + (xcd - r) * q) + off; }
        const int nig = WGM * nN, gid = wgid / nig, fm = gid * WGM, gsz = (nM - fm) < WGM ? (nM - fm) : WGM;
        u.pm = fm + ((wgid % nig) % gsz); u.pn = (wgid % nig) / gsz; return true;
    }
};
template <class Epi>
__device__ __forceinline__ void gemm_phase(PG8_LAS unsigned char* lds, const Gemm g, const StaticOrder& S, const Epi& E) {
    const int tid = tidx(), wid = __builtin_amdgcn_readfirstlane(tid >> 6), lane = tid & 63, wr = wid >> 2, wc = wid & 3, fr = lane & 15, fq = lane >> 4;
    const int K = g.K, nt = K / BK;
    unsigned voffA[2], voffB[2];
#pragma unroll
    for (int i = 0; i < 2; ++i) { int R, C; stage_rc(tid * 16 + i * 8192, R, C); const int Rb = (R & ~31) + perm32(R & 31); voffA[i] = (unsigned)(R * K + C) * 2u; voffB[i] = (unsigned)(Rb * K + C) * 2u; }
    const size_t kstep = (size_t)(BK * 2);
    const size_t hstep = (size_t)HALF * K * 2;
    const size_t tstep = 2 * hstep;
    const unsigned ldsw = (unsigned)wid * 1024u;
    const int aoff = lds_byte(wr * 64 + fr, fq * 8), boff = lds_byte(wc * 32 + fr, fq * 8);
#define PG8_SA(b, h) (((b) * 2 + (h)) * HTB)
#define PG8_SB(b, h) ((4 + (b) * 2 + (h)) * HTB)
#define PG8_STAGE(bufoff, gbase, voff) do { _Pragma("unroll") for (int _i = 0; _i < 2; ++_i) \
        __builtin_amdgcn_global_load_lds((const unsigned*)((const char*)(gbase) + (voff)[_i]), (PG8_LAS unsigned*)(lds + (bufoff) + ldsw + _i * 8192), 16, 0, 0); } while (0)
#define PG8_LDA(dst, b, h) do { _Pragma("unroll") for (int m = 0; m < 4; ++m) _Pragma("unroll") for (int k = 0; k < 2; ++k) dst[m][k] = *(const PG8_LAS bf16x8*)(lds + PG8_SA(b, h) + aoff + m * 2048 + k * 1024); } while (0)
#define PG8_LDB(dst, b, h) do { _Pragma("unroll") for (int n = 0; n < 2; ++n) _Pragma("unroll") for (int k = 0; k < 2; ++k) dst[n][k] = *(const PG8_LAS bf16x8*)(lds + PG8_SB(b, h) + boff + n * 2048 + k * 1024); } while (0)
#define PG8_MMA(ai, bj, At, Bt) do { __builtin_amdgcn_s_setprio(1); _Pragma("unroll") for (int m = 0; m < 4; ++m) _Pragma("unroll") for (int n = 0; n < 2; ++n) _Pragma("unroll") for (int k = 0; k < 2; ++k) \
        acc[ai][bj][m][n] = __builtin_amdgcn_mfma_f32_16x16x32_bf16(Bt[n][k], At[m][k], acc[ai][bj][m][n], 0, 0, 0); __builtin_amdgcn_s_setprio(0); } while (0)
#define PG8_WAIT_V(n) asm volatile("s_waitcnt vmcnt(" #n ")" ::: "memory")
#define PG8_WAIT_L(n) asm volatile("s_waitcnt lgkmcnt(" #n ")" ::: "memory")
#define PG8_BAR __builtin_amdgcn_s_barrier()
#define PG8_SCHED __builtin_amdgcn_sched_barrier(0)
    Unit cur, nxt; int ui = 0;
    if (!S.next(0, cur)) return;
    f32x4 acc[2][2][4][2];
#pragma unroll
    for (int a = 0; a < 2; ++a)
#pragma unroll
        for (int b = 0; b < 2; ++b)
#pragma unroll
            for (int m = 0; m < 4; ++m)
#pragma unroll
                for (int n = 0; n < 2; ++n) acc[a][b][m][n] = (f32x4){0.f, 0.f, 0.f, 0.f};
    bf16x8 At[4][2], B0[2][2], B1[2][2];
    const char* cA = (const char*)g.A + (size_t)cur.pm * tstep; const char* cB = (const char*)g.Bt + (size_t)cur.pn * tstep;
    PG8_STAGE(PG8_SB(0, 0), cB, voffB); PG8_STAGE(PG8_SB(0, 1), cB + hstep, voffB); PG8_STAGE(PG8_SA(0, 0), cA, voffA); PG8_STAGE(PG8_SA(0, 1), cA + hstep, voffA);
    if (wr == 1) PG8_BAR;
    PG8_WAIT_V(2); PG8_BAR;
    PG8_STAGE(PG8_SB(1, 0), cB + kstep, voffB); PG8_STAGE(PG8_SA(1, 0), cA + kstep, voffA); PG8_STAGE(PG8_SB(1, 1), cB + hstep + kstep, voffB);
    PG8_WAIT_V(6); PG8_BAR;
    for (;;) {
        const bool has_next = S.next(ui + 1, nxt);
        const char* nA = has_next ? (const char*)g.A + (size_t)nxt.pm * tstep : cA; const char* nB = has_next ? (const char*)g.Bt + (size_t)nxt.pn * tstep : cB;
        for (int t = 0; t < nt; t += 2) {
            const bool last = (t == nt - 2);
            E.mid(acc, cur, t, wr, wc, fr, fq);
            const char* a1 = cA + (size_t)(t + 1) * kstep;
            const char* a2 = last ? nA : cA + (size_t)(t + 2) * kstep; const char* b2 = last ? nB : cB + (size_t)(t + 2) * kstep;
            const char* a3 = a2 + kstep; const char* b3 = b2 + kstep;
            PG8_LDB(B0, 0, 0); PG8_LDB(B1, 0, 1); PG8_SCHED; PG8_LDA(At, 0, 0); PG8_STAGE(PG8_SA(1, 1), a1 + hstep, voffA);
            PG8_WAIT_V(8); PG8_WAIT_L(0); PG8_BAR; PG8_MMA(0, 0, At, B0); PG8_MMA(0, 1, At, B1); PG8_BAR; PG8_SCHED;
            PG8_LDA(At, 0, 1); PG8_STAGE(PG8_SB(0, 0), b2, voffB); PG8_STAGE(PG8_SB(0, 1), b2 + hstep, voffB); PG8_STAGE(PG8_SA(0, 0), a2, voffA);
            PG8_WAIT_V(8); PG8_WAIT_L(0); PG8_BAR; PG8_MMA(1, 0, At, B0); PG8_MMA(1, 1, At, B1); PG8_BAR; PG8_SCHED;
            PG8_LDB(B0, 1, 0); PG8_LDB(B1, 1, 1); PG8_SCHED; PG8_LDA(At, 1, 0); PG8_STAGE(PG8_SA(0, 1), a2 + hstep, voffA);
            PG8_WAIT_V(8); PG8_WAIT_L(0); PG8_BAR; PG8_MMA(0, 0, At, B0); PG8_MMA(0, 1, At, B1); PG8_BAR; PG8_SCHED;
            PG8_LDA(At, 1, 1); PG8_STAGE(PG8_SB(1, 0), b3, voffB); PG8_STAGE(PG8_SB(1, 1), b3 + hstep, voffB); PG8_STAGE(PG8_SA(1, 0), a3, voffA);
            PG8_WAIT_V(8); PG8_WAIT_L(0); PG8_BAR; PG8_MMA(1, 0, At, B0); PG8_MMA(1, 1, At, B1); PG8_BAR; PG8_SCHED;
        }
        if (wr == 0) PG8_BAR;
        E(acc, cur, wr, wc, fr, fq);
        if (!has_next) break;
#pragma unroll
        for (int a = 0; a < 2; ++a)
#pragma unroll
            for (int b = 0; b < 2; ++b)
#pragma unroll
                for (int m = 0; m < 4; ++m)
#pragma unroll
                    for (int n = 0; n < 2; ++n) acc[a][b][m][n] = (f32x4){0.f, 0.f, 0.f, 0.f};
        cur = nxt; cA = nA; cB = nB; ++ui;
        if (wr == 1) PG8_BAR;
    }
    PG8_WAIT_V(0);
    PG8_BAR;
#undef PG8_SA
#undef PG8_SB
#undef PG8_STAGE
#undef PG8_LDA
#undef PG8_LDB
#undef PG8_MMA
#undef PG8_WAIT_V
#undef PG8_WAIT_L
#undef PG8_BAR
#undef PG8_SCHED
}
}

typedef f32x4 AccT[2][2][4][2];

__device__ __forceinline__ u32x4 pack8(const f32x4& a, const f32x4& b) { u32x4 w; w[0] = cvt_pk_bf16(a[0], a[1]); w[1] = cvt_pk_bf16(a[2], a[3]); w[2] = cvt_pk_bf16(b[0], b[1]); w[3] = cvt_pk_bf16(b[2], b[3]); return w; }
struct EpiWin {
    bf16_t* zA; bf16_t* zG;
    __device__ __forceinline__ void operator()(const AccT& acc, const pg8::Unit& u, int wr, int wc, int fr, int fq) const {
        const int row0 = u.pm * 256 + wr * 64 + fr;
        const int pn = u.pn;
        bf16_t* base; int ld, colt, mode;
        if (pn < 21) { base = zA; ld = ZAW; colt = pn * 256; mode = (pn >= 3 && pn < 6) ? 1 : 0; }
        else { base = zG; ld = ZGW; colt = (pn - 21) * 256; mode = 2; }
        const int col0 = colt + wc * 32 + 8 * fq;
#pragma unroll
        for (int ai = 0; ai < 2; ++ai)
#pragma unroll
            for (int m = 0; m < 4; ++m) {
                bf16_t* rowp = base + (size_t)(row0 + ai * 128 + m * 16) * ld + col0;
#pragma unroll
                for (int bj = 0; bj < 2; ++bj) {
                    f32x4 v0 = acc[ai][bj][m][0], v1 = acc[ai][bj][m][1];
                    if (mode == 1) {
#pragma unroll
                        for (int i = 0; i < 4; ++i) { v0[i] = gelu_tanh(v0[i]); v1[i] = gelu_tanh(v1[i]); }
                    } else if (mode == 2) {
#pragma unroll
                        for (int i = 0; i < 4; ++i) { v0[i] = sigmoidf_(v0[i]); v1[i] = sigmoidf_(v1[i]); }
                    }
                    *(u32x4*)(rowp + bj * 128) = pack8(v0, v1);
                }
            }
    }
};
struct EpiBf16 {
    bf16_t* O; int ld;
    __device__ __forceinline__ void operator()(const AccT& acc, const pg8::Unit& u, int wr, int wc, int fr, int fq) const {
        const int row0 = u.pm * 256 + wr * 64 + fr, col0 = u.pn * 256 + wc * 32 + 8 * fq;
#pragma unroll
        for (int ai = 0; ai < 2; ++ai)
#pragma unroll
            for (int m = 0; m < 4; ++m) {
                bf16_t* rowp = O + (size_t)(row0 + ai * 128 + m * 16) * ld + col0;
#pragma unroll
                for (int bj = 0; bj < 2; ++bj) *(u32x4*)(rowp + bj * 128) = pack8(acc[ai][bj][m][0], acc[ai][bj][m][1]);
            }
    }
};
struct EpiF32 {
    float* C; int ld;
    __device__ __forceinline__ void operator()(const AccT& acc, const pg8::Unit& u, int wr, int wc, int fr, int fq) const {
        const int row0 = u.pm * 256 + wr * 64 + fr, col0 = u.pn * 256 + wc * 32 + 8 * fq;
#pragma unroll
        for (int ai = 0; ai < 2; ++ai)
#pragma unroll
            for (int m = 0; m < 4; ++m) {
                float* rowp = C + (size_t)(row0 + ai * 128 + m * 16) * ld + col0;
#pragma unroll
                for (int bj = 0; bj < 2; ++bj) { *(f32x4*)(rowp + bj * 128) = acc[ai][bj][m][0]; *(f32x4*)(rowp + bj * 128 + 4) = acc[ai][bj][m][1]; }
            }
    }
};
struct EpiGlu {
    bf16_t* O;
    __device__ __forceinline__ void operator()(const AccT& acc, const pg8::Unit& u, int wr, int wc, int fr, int fq) const {
        const int row0 = u.pm * 256 + wr * 64 + fr, col0 = u.pn * 128 + wc * 32 + 8 * fq;
#pragma unroll
        for (int ai = 0; ai < 2; ++ai)
#pragma unroll
            for (int m = 0; m < 4; ++m) {
                bf16_t* rowp = O + (size_t)(row0 + ai * 128 + m * 16) * YCW + col0;
                f32x4 o0, o1;
#pragma unroll
                for (int i = 0; i < 4; ++i) { o0[i] = acc[ai][0][m][0][i] * sigmoidf_(acc[ai][1][m][0][i]); o1[i] = acc[ai][0][m][1][i] * sigmoidf_(acc[ai][1][m][1][i]); }
                *(u32x4*)(rowp) = pack8(o0, o1);
            }
    }
};
struct EpiMergeF {
    bf16_t* mb; const bf16_t* zG;
    __device__ __forceinline__ void rescale(AccT& acc, const pg8::Unit& u, int b, int wr, int wc, int fr, int fq) const {
        int zz = 0; asm volatile("" : "+v"(zz));
        const int row0 = u.pm * 256 + wr * 64 + fr + zz, col0 = u.pn * 256 + wc * 32 + 8 * fq;
#pragma unroll
        for (int ai = 0; ai < 2; ++ai)
#pragma unroll
            for (int m = 0; m < 4; ++m) {
                const bf16_t* gp = zG + (size_t)(row0 + ai * 128 + m * 16) * ZGW + b * 1024 + col0;
#pragma unroll
                for (int bj = 0; bj < 2; ++bj) {
                    const u32x4 g0 = *(const u32x4*)(gp + bj * 128), g1 = *(const u32x4*)(gp + 1024 + bj * 128);
#pragma unroll
                    for (int e = 0; e < 4; ++e) {
                        const float rlo = bflo(g0[e]) * __builtin_amdgcn_rcpf(bflo(g1[e])), rhi = bfhi(g0[e]) * __builtin_amdgcn_rcpf(bfhi(g1[e]));
                        acc[ai][bj][m][e >> 1][(e & 1) * 2] *= rlo; acc[ai][bj][m][e >> 1][(e & 1) * 2 + 1] *= rhi;
                    }
                }
                __builtin_amdgcn_sched_barrier(0);
            }
    }
    __device__ __forceinline__ void operator()(const AccT& acc, const pg8::Unit& u, int wr, int wc, int fr, int fq) const {
        const int row0 = u.pm * 256 + wr * 64 + fr, col0 = u.pn * 256 + wc * 32 + 8 * fq;
#pragma unroll
        for (int ai = 0; ai < 2; ++ai)
#pragma unroll
            for (int m = 0; m < 4; ++m) {
                const size_t r = (size_t)(row0 + ai * 128 + m * 16);
                bf16_t* rowp = mb + r * 1024 + col0; const bf16_t* gp = zG + r * ZGW + 3072 + col0;
#pragma unroll
                for (int bj = 0; bj < 2; ++bj) {
                    const f32x4 v0 = acc[ai][bj][m][0], v1 = acc[ai][bj][m][1];
                    const u32x4 g = *(const u32x4*)(gp + bj * 128);
                    f32x4 o0, o1;
                    o0[0] = v0[0] * bflo(g[0]); o0[1] = v0[1] * bfhi(g[0]); o0[2] = v0[2] * bflo(g[1]); o0[3] = v0[3] * bfhi(g[1]);
                    o1[0] = v1[0] * bflo(g[2]); o1[1] = v1[1] * bfhi(g[2]); o1[2] = v1[2] * bflo(g[3]); o1[3] = v1[3] * bfhi(g[3]);
                    *(u32x4*)(rowp + bj * 128) = pack8(o0, o1);
                }
            }
    }
};

enum { M_BF16 = 0, M_WIN, M_F32, M_GLU, M_MERGE };
struct EpiUni {
    int mode; void* O; int ld; const bf16_t* zG; int goff; bf16_t* O2;
    __device__ __forceinline__ void mid(AccT& acc, const pg8::Unit& u, int t, int wr, int wc, int fr, int fq) const {
        if (mode == M_MERGE && (t == 12 || t == 16 || t == 28)) { EpiMergeF E; E.mb = (bf16_t*)O; E.zG = zG; E.rescale(acc, u, t == 12 ? 0 : (t == 16 ? 1 : 2), wr, wc, fr, fq); }
    }
    __device__ __forceinline__ void operator()(const AccT& acc, const pg8::Unit& u, int wr, int wc, int fr, int fq) const {
        if (mode == M_F32) { EpiF32 E; E.C = (float*)O; E.ld = ld; E(acc, u, wr, wc, fr, fq); }
        else if (mode == M_GLU) { EpiGlu E; E.O = (bf16_t*)O; E(acc, u, wr, wc, fr, fq); }
        else if (mode == M_MERGE) { EpiMergeF E; E.mb = (bf16_t*)O; E.zG = zG; E(acc, u, wr, wc, fr, fq); }
        else if (mode == M_WIN) { EpiWin E; E.zA = (bf16_t*)O; E.zG = O2; E(acc, u, wr, wc, fr, fq); }
        else { EpiBf16 E; E.O = (bf16_t*)O; E.ld = ld; E(acc, u, wr, wc, fr, fq); }
    }
};

struct ConvJob { const float* s; bf16_t* d; int N, ldd, nbase; bool glu, valid; };
constexpr int CONV_NJ = 12;
__device__ __forceinline__ int conv_total() {
    const int Ks[12] = {1024, 768, 1024, 768, 256, 768, 768, 1024, 1024, 3072, 64, 64};
    const int Ns[12] = {NIN, 1536, 1536, 1024, 1024, 1024, 1024, 1024, 6144, 1024, 64, 64};
    const int nbs[12] = {1, 1, 1, 1, 1, 1, 1, 1, 1, 1, 12, 12};
    int tot = 0;
#pragma unroll
    for (int j = 0; j < CONV_NJ; ++j) tot += (Ks[j] / 64) * (Ns[j] / 64) * nbs[j];
    return tot;
}
__device__ __forceinline__ ConvJob conv_decode(const Args& a, int l, int t, int nconv) {
    const int Ks[12] = {1024, 768, 1024, 768, 256, 768, 768, 1024, 1024, 3072, 64, 64};
    const int Ns[12] = {NIN, 1536, 1536, 1024, 1024, 1024, 1024, 1024, 6144, 1024, 64, 64};
    const int nbs[12] = {1, 1, 1, 1, 1, 1, 1, 1, 1, 1, 12, 12};
    const int srcs[12] = {I_WIN, I_SGLU, I_MEMWKV, I_PA, I_PB, I_PC, I_PX, I_WOUT, I_FUP, I_FDOWN, I_LWA, I_LWX};
    const size_t dsts[12] = {WS_WINT, WS_GLUT, WS_WKVT, WS_PAT, WS_PAT, WS_PAT, WS_PAT, WS_WOUTT, WS_UPT, WS_DOWNT, WS_WAT, WS_WXT};
    const int ldds[12] = {1024, 768, 1024, YCW, YCW, YCW, YCW, 1024, 1024, 3072, 64, 64};
    const int koffs[12] = {0, 0, 0, YC_A, YC_B, YC_C, YC_X, 0, 0, 0, 0, 0};
    ConvJob jb; jb.valid = t < nconv; jb.s = nullptr; jb.d = nullptr; jb.N = 64; jb.ldd = 64; jb.nbase = 0; jb.glu = false;
    if (!jb.valid) return jb;
    int st = 0, j = 0, K = 64, N = 64, nb = 1, si = 0, ldd = 64, koff = 0; size_t dz = 0;
    int acc = 0;
#pragma unroll
    for (int q = 0; q < CONV_NJ; ++q) { const int cnt = (Ks[q] / 64) * (Ns[q] / 64) * nbs[q]; if (t >= acc) { j = q; st = acc; K = Ks[q]; N = Ns[q]; nb = nbs[q]; si = srcs[q]; dz = dsts[q]; ldd = ldds[q]; koff = koffs[q]; } acc += cnt; }
    const int tile = t - st, tk = K / 64, tn = N / 64, per = tk * tn;
    const int bi = tile / per, tt = tile % per, kt = tt / tn, nt = tt % tn;
    jb.s = inp(a, si) + (size_t)l * K * N * nb + (size_t)bi * K * N + (size_t)(kt * 64) * N + nt * 64;
    jb.d = (bf16_t*)(wsp(a) + dz) + (size_t)bi * K * N + koff + kt * 64;
    jb.N = N; jb.ldd = ldd; jb.nbase = nt * 64; jb.glu = (j == 1);
    return jb;
}
__device__ void s5_param_tile(const Args& a, int l, int g, float* lds) {
    const int tid = tidx();
    float* zre = lds; float* zim = lds + 64;
    float* abar = (float*)(wsp(a) + WS_ABAR); float* abarl = (float*)(wsp(a) + WS_ABARL);
    if (tid < 64) {
        const int p = tid;
        const float dt = expf(inp(a, I_SLOGDT)[l * 48 + g]);
        const float lr = inp(a, I_SARE)[(l * 48 + g) * 64 + p], li = inp(a, I_SAIM)[(l * 48 + g) * 64 + p];
        const float mag = expf(lr * dt);
        const float abr = mag * cosf(li * dt), abi = mag * sinf(li * dt);
        const float den = lr * lr + li * li;
        zre[p] = ((abr - 1.0f) * lr + abi * li) / den;
        zim[p] = (abi * lr - (abr - 1.0f) * li) / den;
        abar[(g * 64 + p) * 2] = abr; abar[(g * 64 + p) * 2 + 1] = abi;
        float pr = abr, pi = abi;
        for (int i = 0; i < 7; ++i) { const float nr = pr * pr - pi * pi, ni = 2.0f * pr * pi; pr = nr; pi = ni; }
        abarl[(g * 64 + p) * 2] = pr; abarl[(g * 64 + p) * 2 + 1] = pi;
    }
    __syncthreads();
    bf16_t* bbt = (bf16_t*)(wsp(a) + WS_BBART) + (size_t)g * 128 * 16;
    bf16_t* cm = (bf16_t*)(wsp(a) + WS_CMAT) + (size_t)g * 16 * 128;
    for (int e = tid; e < 1024; e += 512) {
        const int p = e >> 4, h = e & 15;
        const float br = inp(a, I_SBRE)[((size_t)(l * 48 + g) * 64 + p) * 16 + h], bi = inp(a, I_SBIM)[((size_t)(l * 48 + g) * 64 + p) * 16 + h];
        bbt[p * 16 + h] = f2bf(zre[p] * br - zim[p] * bi);
        bbt[(64 + p) * 16 + h] = f2bf(zre[p] * bi + zim[p] * br);
    }
    for (int e = tid; e < 2048; e += 512) {
        const int h = e >> 7, k = e & 127;
        const float v = (k < 64) ? inp(a, I_SCRE)[((size_t)(l * 48 + g) * 16 + h) * 64 + k] : -inp(a, I_SCIM)[((size_t)(l * 48 + g) * 16 + h) * 64 + (k - 64)];
        cm[h * 128 + k] = f2bf(v);
    }
    __syncthreads();
}

__device__ __forceinline__ float wave_sum(float v) {
#pragma unroll
    for (int o = 32; o > 0; o >>= 1) v += __shfl_xor(v, o);
    return v;
}

__device__ void phase_convert(const Args& a, int l, float* lds) {
    const int nconv = conv_total();
    const int n_s5 = 48, n_mem = 64;
    const int total = nconv + n_s5 + n_mem;
    const int tid = tidx();
    for (int t0 = blockIdx.x; t0 < nconv; t0 += 4 * gridDim.x) {
        ConvJob jb[4]; float v[4][8];
#pragma unroll
        for (int q = 0; q < 4; ++q) {
            jb[q] = conv_decode(a, l, t0 + q * (int)gridDim.x, nconv);
            if (jb[q].valid) {
#pragma unroll
                for (int i = 0; i < 8; ++i) { const int idx = i * 512 + tid, r = idx >> 6, c = idx & 63; v[q][i] = jb[q].s[(size_t)r * jb[q].N + c]; }
            }
        }
#pragma unroll
        for (int q = 0; q < 4; ++q) {
            if (jb[q].valid) {
#pragma unroll
                for (int i = 0; i < 8; ++i) { const int idx = i * 512 + tid, r = idx >> 6, c = idx & 63; lds[q * 4160 + r * 65 + c] = v[q][i]; }
            }
        }
        __syncthreads();
#pragma unroll
        for (int q = 0; q < 4; ++q) {
            if (jb[q].valid) {
#pragma unroll
                for (int i = 0; i < 4; ++i) {
                    const int idx = i * 512 + tid, rn = idx >> 5, ck = (idx & 31) * 2;
                    int n = jb[q].nbase + rn;
                    if (jb[q].glu) { n = (n < 768) ? ((n >> 7) * 256 + (n & 127)) : (((n - 768) >> 7) * 256 + 128 + ((n - 768) & 127)); }
                    *(unsigned*)(jb[q].d + (size_t)n * jb[q].ldd + ck) = cvt_pk_bf16(lds[q * 4160 + ck * 65 + rn], lds[q * 4160 + (ck + 1) * 65 + rn]);
                }
            }
        }
        __syncthreads();
    }
    for (int t = nconv + blockIdx.x; t < total; t += gridDim.x) {
        if (t < nconv + n_s5) {

            s5_param_tile(a, l, t - nconv, lds);
        } else {
            const int row = (t - nconv - n_s5) * 8 + (tidx() >> 6), lane = tidx() & 63;
            const float* x = inp(a, I_MEM) + (size_t)row * 1024; const float* g = inp(a, I_GMEM) + l * 1024;
            f32x4 v[4]; float ss = 0.f;
#pragma unroll
            for (int i = 0; i < 4; ++i) { v[i] = *(const f32x4*)(x + i * 256 + lane * 4); ss += v[i][0] * v[i][0] + v[i][1] * v[i][1] + v[i][2] * v[i][2] + v[i][3] * v[i][3]; }
            ss = wave_sum(ss); const float sc = rsqrtf(ss * (1.0f / 1024.0f) + EPS);
            bf16_t* o = (bf16_t*)(wsp(a) + WS_MEMN) + (size_t)row * 1024;
#pragma unroll
            for (int i = 0; i < 4; ++i) { const f32x4 gg = *(const f32x4*)(g + i * 256 + lane * 4); u32x2 w; w.x = cvt_pk_bf16(v[i][0] * sc * gg[0], v[i][1] * sc * gg[1]); w.y = cvt_pk_bf16(v[i][2] * sc * gg[2], v[i][3] * sc * gg[3]); *(u32x2*)(o + i * 256 + lane * 4) = w; }
        }
    }
}

__device__ void phase_prenorm(const float* __restrict__ x, const float* __restrict__ g, bf16_t* __restrict__ hb) {
    const int lane = tidx() & 63, w = tidx() >> 6;
    for (int t = blockIdx.x; t < LSEQ / 8; t += gridDim.x) {
        const int row = t * 8 + w;
        const float* xr = x + (size_t)row * 1024;
        f32x4 v[4]; float ss = 0.f;
#pragma unroll
        for (int i = 0; i < 4; ++i) { v[i] = *(const f32x4*)(xr + i * 256 + lane * 4); ss += v[i][0] * v[i][0] + v[i][1] * v[i][1] + v[i][2] * v[i][2] + v[i][3] * v[i][3]; }
        ss = wave_sum(ss); const float sc = rsqrtf(ss * (1.0f / 1024.0f) + EPS);
        bf16_t* o = hb + (size_t)row * 1024;
#pragma unroll
        for (int i = 0; i < 4; ++i) { const f32x4 gg = *(const f32x4*)(g + i * 256 + lane * 4); u32x2 wv; wv.x = cvt_pk_bf16(v[i][0] * sc * gg[0], v[i][1] * sc * gg[1]); wv.y = cvt_pk_bf16(v[i][2] * sc * gg[2], v[i][3] * sc * gg[3]); *(u32x2*)(o + i * 256 + lane * 4) = wv; }
    }
}

template <bool WITH_H>
__device__ void phase_postnorm(const float* xin, const bf16_t* __restrict__ y, const float* __restrict__ gpost, float* xout,
                               const float* __restrict__ gpre, bf16_t* __restrict__ hb) {
    const int lane = tidx() & 63, w = tidx() >> 6;
    f32x4 gp[2][2], gq[2][2];
#pragma unroll
    for (int i = 0; i < 2; ++i)
#pragma unroll
        for (int h = 0; h < 2; ++h) { gp[i][h] = *(const f32x4*)(gpost + i * 512 + lane * 8 + h * 4); if (WITH_H) gq[i][h] = *(const f32x4*)(gpre + i * 512 + lane * 8 + h * 4); }
    for (int t = blockIdx.x; t < LSEQ / 32; t += gridDim.x) {
        const int row0 = t * 32 + w * 4;
        u32x4 yv[4][2]; f32x4 xv[4][2][2];
#pragma unroll
        for (int r = 0; r < 4; ++r)
#pragma unroll
            for (int i = 0; i < 2; ++i) {
                yv[r][i] = *(const u32x4*)(y + (size_t)(row0 + r) * 1024 + i * 512 + lane * 8);
                xv[r][i][0] = *(const f32x4*)(xin + (size_t)(row0 + r) * 1024 + i * 512 + lane * 8);
                xv[r][i][1] = *(const f32x4*)(xin + (size_t)(row0 + r) * 1024 + i * 512 + lane * 8 + 4);
            }
#pragma unroll
        for (int r = 0; r < 4; ++r) {
            float yf[2][8]; float ss = 0.f;
#pragma unroll
            for (int i = 0; i < 2; ++i)
#pragma unroll
                for (int e = 0; e < 4; ++e) { yf[i][2 * e] = bflo(yv[r][i][e]); yf[i][2 * e + 1] = bfhi(yv[r][i][e]); ss += yf[i][2 * e] * yf[i][2 * e] + yf[i][2 * e + 1] * yf[i][2 * e + 1]; }
            ss = wave_sum(ss); const float sc = rsqrtf(ss * (1.0f / 1024.0f) + EPS);
            float s2 = 0.f;
#pragma unroll
            for (int i = 0; i < 2; ++i)
#pragma unroll
                for (int h = 0; h < 2; ++h) {
#pragma unroll
                    for (int e = 0; e < 4; ++e) { const float v = xv[r][i][h][e] + yf[i][h * 4 + e] * sc * gp[i][h][e]; xv[r][i][h][e] = v; s2 += v * v; }
                    *(f32x4*)(xout + (size_t)(row0 + r) * 1024 + i * 512 + lane * 8 + h * 4) = xv[r][i][h];
                }
            if (WITH_H) {
                s2 = wave_sum(s2); const float sc2 = rsqrtf(s2 * (1.0f / 1024.0f) + EPS);
#pragma unroll
                for (int i = 0; i < 2; ++i) {
                    f32x4 o0, o1;
#pragma unroll
                    for (int e = 0; e < 4; ++e) { o0[e] = xv[r][i][0][e] * sc2 * gq[i][0][e]; o1[e] = xv[r][i][1][e] * sc2 * gq[i][1][e]; }
                    u32x4 wv; wv[0] = cvt_pk_bf16(o0[0], o0[1]); wv[1] = cvt_pk_bf16(o0[2], o0[3]); wv[2] = cvt_pk_bf16(o1[0], o1[1]); wv[3] = cvt_pk_bf16(o1[2], o1[3]);
                    *(u32x4*)(hb + (size_t)(row0 + r) * 1024 + i * 512 + lane * 8) = wv;
                }
            }
        }
    }
}

#define WSYNC() __syncthreads()
template <int PASS>
__device__ void s5_item(const Args& a, int l, int item, float* wl  ) {
    const int lane = tidx() & 63, fr = lane & 15, fq = lane >> 4;
    const int g = item % 48, chunk = item / 48;
    const bf16_t* zA = (const bf16_t*)(wsp(a) + WS_ZA);
    const bf16_t* bbt = (const bf16_t*)(wsp(a) + WS_BBART) + (size_t)g * 128 * 16;
    const bf16_t* cm = (const bf16_t*)(wsp(a) + WS_CMAT) + (size_t)g * 16 * 128;
    const float* abar = (const float*)(wsp(a) + WS_ABAR);
    float* s5c = (float*)(wsp(a) + WS_S5C);
    const bf16x8 zero8 = {0, 0, 0, 0, 0, 0, 0, 0};
    bf16x8 bB[8];
#pragma unroll
    for (int cb = 0; cb < 8; ++cb) bB[cb] = (fq < 2) ? *(const bf16x8*)(bbt + (cb * 16 + fr) * 16 + fq * 8) : zero8;
    bf16x8 bC[4];
    float dsk = 0.f;
    if (PASS == 2) {
#pragma unroll
        for (int ks = 0; ks < 4; ++ks) bC[ks] = *(const bf16x8*)(cm + fr * 128 + ks * 32 + fq * 8);
        dsk = inp(a, I_SD)[l * 768 + g * 16 + fr];
    }
    const float ar = abar[(g * 64 + lane) * 2], ai = abar[(g * 64 + lane) * 2 + 1];
    float xr = 0.f, xi = 0.f;
    if (PASS == 2) { xr = s5c[((size_t)(chunk * 48 + g) * 64 + lane) * 2]; xi = s5c[((size_t)(chunk * 48 + g) * 64 + lane) * 2 + 1]; }
    const int t0 = chunk * S5_LC;
    bf16x8 aUn[2];
#pragma unroll
    for (int rb = 0; rb < 2; ++rb) aUn[rb] = (fq < 2) ? *(const bf16x8*)(zA + (size_t)(t0 + rb * 16 + fr) * ZAW + OFF_US + g * 16 + fq * 8) : zero8;
    for (int sub = 0; sub < S5_LC / 32; ++sub) {
        const int ts = t0 + sub * 32;
        bf16x8 aUc[2]; aUc[0] = aUn[0]; aUc[1] = aUn[1];
        if (sub + 1 < S5_LC / 32) {
#pragma unroll
            for (int rb = 0; rb < 2; ++rb) aUn[rb] = (fq < 2) ? *(const bf16x8*)(zA + (size_t)(ts + 32 + rb * 16 + fr) * ZAW + OFF_US + g * 16 + fq * 8) : zero8;
        }
        bf16_t uq[2][4];
        if (PASS == 2) {
#pragma unroll
            for (int rb = 0; rb < 2; ++rb)
#pragma unroll
                for (int j = 0; j < 4; ++j) uq[rb][j] = zA[(size_t)(ts + rb * 16 + fq * 4 + j) * ZAW + OFF_US + g * 16 + fr];
        }
#pragma unroll
        for (int rb = 0; rb < 2; ++rb) {
            const bf16x8 aU = aUc[rb];
#pragma unroll
            for (int cb = 0; cb < 8; ++cb) {
                f32x4 c = {0.f, 0.f, 0.f, 0.f};
                c = __builtin_amdgcn_mfma_f32_16x16x32_bf16(aU, bB[cb], c, 0, 0, 0);
#pragma unroll
                for (int j = 0; j < 4; ++j) wl[(rb * 16 + fq * 4 + j) * 132 + cb * 16 + fr] = c[j];
            }
        }
        WSYNC();
#pragma unroll 8
        for (int t = 0; t < 32; ++t) {
            const float br = wl[t * 132 + lane], bi = wl[t * 132 + 64 + lane];
            const float nr = ar * xr - ai * xi + br, ni = ar * xi + ai * xr + bi;
            xr = nr; xi = ni;
            if (PASS == 2) { wl[t * 132 + lane] = xr; wl[t * 132 + 64 + lane] = xi; }
        }
        WSYNC();
        if (PASS == 2) {
#pragma unroll
            for (int rb = 0; rb < 2; ++rb) {
                f32x4 c = {0.f, 0.f, 0.f, 0.f};
#pragma unroll
                for (int ks = 0; ks < 4; ++ks) {
                    const float* xp = wl + (rb * 16 + fr) * 132 + ks * 32 + fq * 8;
                    const f32x4 x0 = *(const f32x4*)xp, x1 = *(const f32x4*)(xp + 4);
                    union { bf16x8 v; unsigned u[4]; } A;
                    A.u[0] = cvt_pk_bf16(x0[0], x0[1]); A.u[1] = cvt_pk_bf16(x0[2], x0[3]); A.u[2] = cvt_pk_bf16(x1[0], x1[1]); A.u[3] = cvt_pk_bf16(x1[2], x1[3]);
                    c = __builtin_amdgcn_mfma_f32_16x16x32_bf16(A.v, bC[ks], c, 0, 0, 0);
                }
                bf16_t* gy = (bf16_t*)(wsp(a) + WS_GY);
#pragma unroll
                for (int j = 0; j < 4; ++j) {
                    const int tok = ts + rb * 16 + fq * 4 + j;
                    const float uu = bf2f(uq[rb][j]);
                    gy[(size_t)tok * 768 + g * 16 + fr] = f2bf(gelu_tanh(c[j] + dsk * uu));
                }
            }
            WSYNC();
        }
    }
    if (PASS == 1) { s5c[((size_t)(chunk * 48 + g) * 64 + lane) * 2] = xr; s5c[((size_t)(chunk * 48 + g) * 64 + lane) * 2 + 1] = xi; }
}

template <int PASS>
__device__ void lru_item(const Args& a, int l, int item, unsigned char* wlb  ) {
    const int lane = tidx() & 63, fr = lane & 15, fq = lane >> 4;
    const int n = item % 12, chunk = item / 12;
    const int ch = n * 64 + lane;
    const bf16_t* zA = (const bf16_t*)(wsp(a) + WS_ZA);
    float* xcf = (float*)wlb;
    float* abuf = (float*)(wlb + 4096);
    bf16_t* xcb = (bf16_t*)(wlb + 8192);
    const bf16_t* waT = (const bf16_t*)(wsp(a) + WS_WAT) + n * 4096;
    const bf16_t* wxT = (const bf16_t*)(wsp(a) + WS_WXT) + n * 4096;
    bf16x8 bWa[4][2], bWx[4][2];
    float ba4[4], bx4[4], sp4[4];
#pragma unroll
    for (int cb = 0; cb < 4; ++cb) {
#pragma unroll
        for (int ks = 0; ks < 2; ++ks) { bWa[cb][ks] = *(const bf16x8*)(waT + (cb * 16 + fr) * 64 + ks * 32 + fq * 8); bWx[cb][ks] = *(const bf16x8*)(wxT + (cb * 16 + fr) * 64 + ks * 32 + fq * 8); }
        const int cc = l * 768 + n * 64 + cb * 16 + fr;
        ba4[cb] = inp(a, I_LBA)[cc]; bx4[cb] = inp(a, I_LBX)[cc];
        const float lam = inp(a, I_LLAM)[cc];
        sp4[cb] = (lam < -20.f) ? -lam : log1pf(__expf(-lam));
    }
    const float w0 = inp(a, I_LCW)[(l * 4 + 0) * 768 + ch], w1 = inp(a, I_LCW)[(l * 4 + 1) * 768 + ch], w2 = inp(a, I_LCW)[(l * 4 + 2) * 768 + ch], w3 = inp(a, I_LCW)[(l * 4 + 3) * 768 + ch];
    const float cbias = inp(a, I_LCB)[l * 768 + ch];
    const int t0 = chunk * LRU_LC;
    float xm3 = 0.f, xm2 = 0.f, xm1 = 0.f;
    if (t0 > 0) { xm3 = bf2f(zA[(size_t)(t0 - 3) * ZAW + OFF_XA + ch]); xm2 = bf2f(zA[(size_t)(t0 - 2) * ZAW + OFF_XA + ch]); xm1 = bf2f(zA[(size_t)(t0 - 1) * ZAW + OFF_XA + ch]); }
    float* lp = (float*)(wsp(a) + WS_LRUP); float* lh = (float*)(wsp(a) + WS_LRUH);
    float h = 0.f, P = 1.f;
    if (PASS == 2) h = lh[(size_t)chunk * 768 + ch];
    bf16_t* ya = (bf16_t*)(wsp(a) + WS_YCAT) + YC_A;
    bf16_t xq[16], gq[16];
#pragma unroll
    for (int t = 0; t < 16; ++t) xq[t] = zA[(size_t)(t0 + t) * ZAW + OFF_XA + ch];
    for (int sub = 0; sub < LRU_LC / 16; ++sub) {
        const int ts = t0 + sub * 16;
        if (PASS == 2) {
#pragma unroll
            for (int t = 0; t < 16; ++t) gq[t] = zA[(size_t)(ts + t) * ZAW + OFF_GA + ch];
        }
#pragma unroll
        for (int t = 0; t < 16; ++t) {
            const float xv = bf2f(xq[t]);
            const float xc = cbias + w0 * xm3 + w1 * xm2 + w2 * xm1 + w3 * xv;
            xm3 = xm2; xm2 = xm1; xm1 = xv;
            xcf[t * 64 + lane] = xc; xcb[t * 72 + lane] = f2bf(xc);
        }
        if (sub + 1 < LRU_LC / 16) {
#pragma unroll
            for (int t = 0; t < 16; ++t) xq[t] = zA[(size_t)(ts + 16 + t) * ZAW + OFF_XA + ch];
        }
        asm volatile("s_waitcnt lgkmcnt(0)" ::: "memory");
        bf16x8 aX[2];
#pragma unroll
        for (int ks = 0; ks < 2; ++ks) aX[ks] = *(const bf16x8*)(xcb + fr * 72 + ks * 32 + fq * 8);
#pragma unroll
        for (int cb = 0; cb < 4; ++cb) {
            f32x4 cA = {0.f, 0.f, 0.f, 0.f}, cX = {0.f, 0.f, 0.f, 0.f};
            cA = __builtin_amdgcn_mfma_f32_16x16x32_bf16(aX[0], bWa[cb][0], cA, 0, 0, 0);
            cA = __builtin_amdgcn_mfma_f32_16x16x32_bf16(aX[1], bWa[cb][1], cA, 0, 0, 0);
            cX = __builtin_amdgcn_mfma_f32_16x16x32_bf16(aX[0], bWx[cb][0], cX, 0, 0, 0);
            cX = __builtin_amdgcn_mfma_f32_16x16x32_bf16(aX[1], bWx[cb][1], cX, 0, 0, 0);
#pragma unroll
            for (int j = 0; j < 4; ++j) {
                const int tok = fq * 4 + j, cc = cb * 16 + fr;
                const float r = sigmoidf_(cA[j] + ba4[cb]), ig = sigmoidf_(cX[j] + bx4[cb]);
                const float la = -8.0f * r * sp4[cb];
                const float av = fexp(la);
                const float xcv = xcf[tok * 64 + cc];
                const float uv = __builtin_amdgcn_sqrtf(fmaxf(1.0f - av * av, 0.0f)) * (ig * xcv);
                abuf[tok * 64 + cc] = av; xcf[tok * 64 + cc] = uv;
            }
        }
        asm volatile("s_waitcnt lgkmcnt(0)" ::: "memory");
#pragma unroll
        for (int t = 0; t < 16; ++t) {
            const float av = abuf[t * 64 + lane], uv = xcf[t * 64 + lane];
            h = av * h + uv; P *= av;
            if (PASS == 2) ya[(size_t)(ts + t) * YCW + ch] = f2bf(h * bf2f(gq[t]));
        }
        asm volatile("s_waitcnt lgkmcnt(0)" ::: "memory");
    }
    if (PASS == 1) { lp[(size_t)chunk * 768 + ch] = P; lh[(size_t)chunk * 768 + ch] = h; }
}

__device__ void dil_attn_tile(const Args& a, int tile, unsigned char* lds) {
    const int tid = tidx(), w = tid >> 6, lane = tid & 63, fr = lane & 15, fq = lane >> 4;
    const int head = tile >> 7, blk = tile & 127;
    const int g = head >> 2;
    const int dil = (g == 0) ? 1 : (g == 1 ? 4 : 16);
    const int r = blk % dil, nb = blk / dil;
    const float slope = exp2f(-8.0f * (float)(head + 1) / 12.0f) * (float)dil;
    const bf16_t* zA = (const bf16_t*)(wsp(a) + WS_ZA);
    bf16_t* Ks = (bf16_t*)lds;
    bf16_t* Vt = (bf16_t*)(lds + 256 * 144);
    constexpr int KS = 72, VS = 264;
    const size_t tq = (size_t)(nb * 128 + w * 16 + fr) * dil + r;
    bf16x8 bQ[2];
#pragma unroll
    for (int ks = 0; ks < 2; ++ks) bQ[ks] = *(const bf16x8*)(zA + tq * ZAW + OFF_Q + head * 64 + ks * 32 + fq * 8);
    const bf16x8 zero8 = {0, 0, 0, 0, 0, 0, 0, 0};
#pragma unroll
    for (int i = 0; i < 4; ++i) {
        const int c = i * 512 + tid, key = c >> 3, part = c & 7;
        const int kidx = nb * 128 + key - 128;
        bf16x8 kv = zero8, vv = zero8;
        if (kidx >= 0) {
            const size_t tok = (size_t)kidx * dil + r;
            kv = *(const bf16x8*)(zA + tok * ZAW + OFF_K + head * 64 + part * 8);
            vv = *(const bf16x8*)(zA + tok * ZAW + OFF_V + head * 64 + part * 8);
        }
        *(bf16x8*)(Ks + key * KS + part * 8) = kv;
#pragma unroll
        for (int e = 0; e < 8; ++e) Vt[(part * 8 + e) * VS + key] = (bf16_t)vv[e];
    }
    __syncthreads();
    f32x4 S[9];
    float mx = -1e30f;
#pragma unroll
    for (int kb = 0; kb < 9; ++kb) {
        f32x4 c = {0.f, 0.f, 0.f, 0.f};
#pragma unroll
        for (int ks = 0; ks < 2; ++ks) {
            const bf16x8 aK = *(const bf16x8*)(Ks + (w * 16 + kb * 16 + fr) * KS + ks * 32 + fq * 8);
            c = __builtin_amdgcn_mfma_f32_16x16x32_bf16(aK, bQ[ks], c, 0, 0, 0);
        }
#pragma unroll
        for (int j = 0; j < 4; ++j) {
            const int ki = w * 16 + kb * 16 + fq * 4 + j;
            const int dist = fr + 128 - kb * 16 - fq * 4 - j;
            const bool valid = (dist >= 0) && (dist <= 128) && (nb * 128 + ki - 128 >= 0);
            const float s = valid ? (c[j] * 0.125f - slope * (float)dist) : -1e30f;
            c[j] = s; mx = fmaxf(mx, s);
        }
        S[kb] = c;
        __builtin_amdgcn_sched_barrier(0);
    }
    mx = fmaxf(mx, __shfl_xor(mx, 16)); mx = fmaxf(mx, __shfl_xor(mx, 32));
    float lsum = 0.f;
    unsigned pk[9][2];
#pragma unroll
    for (int kb = 0; kb < 9; ++kb) {
        float p[4];
#pragma unroll
        for (int j = 0; j < 4; ++j) { p[j] = __expf(S[kb][j] - mx); lsum += p[j]; }
        pk[kb][0] = cvt_pk_bf16(p[0], p[1]); pk[kb][1] = cvt_pk_bf16(p[2], p[3]);
    }
    lsum += __shfl_xor(lsum, 16); lsum += __shfl_xor(lsum, 32);
    f32x4 O[4];
#pragma unroll
    for (int db = 0; db < 4; ++db) O[db] = (f32x4){0.f, 0.f, 0.f, 0.f};
#pragma unroll
    for (int pp = 0; pp < 5; ++pp) {
        union { bf16x8 v; unsigned u[4]; } B;
        B.u[0] = pk[2 * pp][0]; B.u[1] = pk[2 * pp][1];
        if (pp < 4) { B.u[2] = pk[2 * pp + 1][0]; B.u[3] = pk[2 * pp + 1][1]; } else { B.u[2] = 0; B.u[3] = 0; }
#pragma unroll
        for (int db = 0; db < 4; ++db) {
            union { bf16x8 v; u32x2 h[2]; } A;
            A.h[0] = *(const u32x2*)(Vt + (db * 16 + fr) * VS + w * 16 + (2 * pp) * 16 + fq * 4);
            if (pp < 4) A.h[1] = *(const u32x2*)(Vt + (db * 16 + fr) * VS + w * 16 + (2 * pp + 1) * 16 + fq * 4); else A.h[1] = (u32x2){0u, 0u};
            O[db] = __builtin_amdgcn_mfma_f32_16x16x32_bf16(A.v, B.v, O[db], 0, 0, 0);
        }
    }
    const float inv = 1.0f / lsum;
    bf16_t* oatt = (bf16_t*)(wsp(a) + WS_OATT);
#pragma unroll
    for (int db = 0; db < 4; ++db) {
        u32x2 wv; wv.x = cvt_pk_bf16(O[db][0] * inv, O[db][1] * inv); wv.y = cvt_pk_bf16(O[db][2] * inv, O[db][3] * inv);
        *(u32x2*)(oatt + tq * 768 + head * 64 + db * 16 + fq * 4) = wv;
    }
    if (fq == 0) ((float*)(wsp(a) + WS_LSE))[tq * 12 + head] = mx + __logf(lsum);
    __syncthreads();
}

__device__ void cross_attn_tile(const Args& a, int b, int tile, unsigned char* lds) {
    const int tid = tidx(), w = tid >> 6, lane = tid & 63, fr = lane & 15, fq = lane >> 4;
    const int hx = tile >> 7, qb = tile & 127;
    const bf16_t* zA = (const bf16_t*)(wsp(a) + WS_ZA);
    const bf16_t* kvm = (const bf16_t*)(wsp(a) + WS_KVM) + (size_t)b * 256 * 1536;
    constexpr int KS = 200, VS = 136;
    bf16_t* Ks = (bf16_t*)lds;
    bf16_t* Vt = (bf16_t*)(lds + 51200);
    const size_t tq = (size_t)qb * 128 + w * 16 + fr;
    bf16x8 bQ[6];
#pragma unroll
    for (int ks = 0; ks < 6; ++ks) bQ[ks] = *(const bf16x8*)(zA + tq * ZAW + OFF_XQ + hx * 192 + ks * 32 + fq * 8);
    f32x4 O[12];
#pragma unroll
    for (int db = 0; db < 12; ++db) O[db] = (f32x4){0.f, 0.f, 0.f, 0.f};
    float mrun = -1e30f, lrun = 0.f;
    const float scale = 0.07216878364870322f;
#pragma unroll 1
    for (int hf = 0; hf < 2; ++hf) {
#pragma unroll 2
        for (int i = 0; i < 6; ++i) {
            const int c = i * 512 + tid, key = c / 24, part = c % 24;
            const bf16_t* src = kvm + (size_t)(hf * 128 + key) * 1536 + hx * 192 + part * 8;
            *(bf16x8*)(Ks + key * KS + part * 8) = *(const bf16x8*)(src);
            const bf16x8 vv = *(const bf16x8*)(src + 768);
#pragma unroll
            for (int e = 0; e < 8; ++e) Vt[(part * 8 + e) * VS + key] = (bf16_t)vv[e];
        }
        __syncthreads();
        f32x4 S[8];
        float mx = -1e30f;
#pragma unroll
        for (int kb = 0; kb < 8; ++kb) {
            f32x4 c = {0.f, 0.f, 0.f, 0.f};
#pragma unroll
            for (int ks = 0; ks < 6; ++ks) {
                const bf16x8 aK = *(const bf16x8*)(Ks + (kb * 16 + fr) * KS + ks * 32 + fq * 8);
                c = __builtin_amdgcn_mfma_f32_16x16x32_bf16(aK, bQ[ks], c, 0, 0, 0);
            }
#pragma unroll
            for (int j = 0; j < 4; ++j) { c[j] *= scale; mx = fmaxf(mx, c[j]); }
            S[kb] = c;
        }
        mx = fmaxf(mx, __shfl_xor(mx, 16)); mx = fmaxf(mx, __shfl_xor(mx, 32));
        const float mnew = fmaxf(mrun, mx);
        const float alpha = __expf(mrun - mnew);
        mrun = mnew;
        float lsum = 0.f;
        unsigned pk[8][2];
#pragma unroll
        for (int kb = 0; kb < 8; ++kb) {
            float p[4];
#pragma unroll
            for (int j = 0; j < 4; ++j) { p[j] = __expf(S[kb][j] - mnew); lsum += p[j]; }
            pk[kb][0] = cvt_pk_bf16(p[0], p[1]); pk[kb][1] = cvt_pk_bf16(p[2], p[3]);
        }
        lsum += __shfl_xor(lsum, 16); lsum += __shfl_xor(lsum, 32);
        lrun = lrun * alpha + lsum;
#pragma unroll
        for (int db = 0; db < 12; ++db) { O[db][0] *= alpha; O[db][1] *= alpha; O[db][2] *= alpha; O[db][3] *= alpha; }
#pragma unroll
        for (int pp = 0; pp < 4; ++pp) {
            union { bf16x8 v; unsigned u[4]; } B;
            B.u[0] = pk[2 * pp][0]; B.u[1] = pk[2 * pp][1]; B.u[2] = pk[2 * pp + 1][0]; B.u[3] = pk[2 * pp + 1][1];
#pragma unroll
            for (int db = 0; db < 12; ++db) {
                union { bf16x8 v; u32x2 h[2]; } A;
                A.h[0] = *(const u32x2*)(Vt + (db * 16 + fr) * VS + (2 * pp) * 16 + fq * 4);
                A.h[1] = *(const u32x2*)(Vt + (db * 16 + fr) * VS + (2 * pp + 1) * 16 + fq * 4);
                O[db] = __builtin_amdgcn_mfma_f32_16x16x32_bf16(A.v, B.v, O[db], 0, 0, 0);
            }
        }
        __syncthreads();
    }
    const float inv = 1.0f / lrun;
    bf16_t* yx = (bf16_t*)(wsp(a) + WS_YCAT) + YC_X;
#pragma unroll
    for (int db = 0; db < 12; ++db) {
        u32x2 wv; wv.x = cvt_pk_bf16(O[db][0] * inv, O[db][1] * inv); wv.y = cvt_pk_bf16(O[db][2] * inv, O[db][3] * inv);
        *(u32x2*)(yx + tq * YCW + hx * 192 + db * 16 + fq * 4) = wv;
    }
}

__device__ void combine_tile(const Args& a, int tile) {
    const int tid = tidx();
    const size_t tok = (size_t)tile * 16 + (tid >> 5);
    const int j = (tid >> 3) & 3, part = tid & 7;
    const float* lse = (const float*)(wsp(a) + WS_LSE) + tok * 12;
    const float l0 = lse[j], l1 = lse[4 + j], l2 = lse[8 + j];
    const float m = fmaxf(l0, fmaxf(l1, l2));
    float w0 = __expf(l0 - m), w1 = __expf(l1 - m), w2 = __expf(l2 - m);
    const float inv = 1.0f / (w0 + w1 + w2); w0 *= inv; w1 *= inv; w2 *= inv;
    const bf16_t* o = (const bf16_t*)(wsp(a) + WS_OATT) + tok * 768 + j * 64 + part * 8;
    const u32x4 a0 = *(const u32x4*)(o), a1 = *(const u32x4*)(o + 256), a2 = *(const u32x4*)(o + 512);
    u32x4 rr;
#pragma unroll
    for (int e = 0; e < 4; ++e) {
        const float lo = w0 * bflo(a0[e]) + w1 * bflo(a1[e]) + w2 * bflo(a2[e]);
        const float hi = w0 * bfhi(a0[e]) + w1 * bfhi(a1[e]) + w2 * bfhi(a2[e]);
        rr[e] = cvt_pk_bf16(lo, hi);
    }
    *(u32x4*)((bf16_t*)(wsp(a) + WS_YCAT) + tok * YCW + YC_B + j * 64 + part * 8) = rr;
}

constexpr int N_S5_TILES = S5_NCH * 48 / 8;
constexpr int N_LRU_TILES = LRU_NCH * 12 / 8;
constexpr int N_DIL_TILES = 12 * 128;
constexpr int N_X_TILES = 4 * 128;
constexpr int N_COMB_TILES = LSEQ / 16;

#ifndef MIXSEL
#define MIXSEL 15
#endif
__device__ void phase_mix1(const Args& a, int l, int b, unsigned char* lds) {
    const int w = tidx() >> 6;
    for (int t = blockIdx.x; t < N_S5_TILES; t += gridDim.x) s5_item<1>(a, l, t * 8 + w, (float*)(lds + w * 16896));
    asm volatile("" ::: "memory"); __builtin_amdgcn_sched_barrier(0);
    for (int t = blockIdx.x; t < N_LRU_TILES; t += gridDim.x) lru_item<1>(a, l, t * 8 + w, lds + w * 16896);
}
__device__ void phase_carry(const Args& a);
__device__ void phase_mixB(const Args& a, int l, int b, unsigned char* lds) {
    if (blockIdx.x < 8) {
        phase_carry(a);
        for (int t = N_X_TILES - 16 + (int)blockIdx.x; t < N_X_TILES; t += 8) cross_attn_tile(a, b, t, lds);
        return;
    }
    const int nb = gridDim.x - 8, bi = blockIdx.x - 8;
    for (int t = bi; t < N_X_TILES - 16; t += nb) cross_attn_tile(a, b, t, lds);
    asm volatile("" ::: "memory"); __builtin_amdgcn_sched_barrier(0);
    for (int t = bi; t < N_DIL_TILES; t += nb) dil_attn_tile(a, t, lds);
}
__device__ void phase_mix2(const Args& a, int l, unsigned char* lds) {
    const int w = tidx() >> 6;
    DM(4) for (int t = blockIdx.x; t < N_S5_TILES; t += gridDim.x) s5_item<2>(a, l, t * 8 + w, (float*)(lds + w * 16896));
    DM(5) for (int t = blockIdx.x; t < N_LRU_TILES; t += gridDim.x) lru_item<2>(a, l, t * 8 + w, lds + w * 16896);
}

__device__ void phase_carry(const Args& a) {
    const int gt = blockIdx.x * 512 + tidx();
    if (gt < 3072) {
        float* s5c = (float*)(wsp(a) + WS_S5C);
        const float* abarl = (const float*)(wsp(a) + WS_ABARL);
        const float ar = abarl[gt * 2], ai = abarl[gt * 2 + 1];
        float xr = 0.f, xi = 0.f;
#pragma unroll 8
        for (int c = 0; c < S5_NCH; ++c) {
            float* p = s5c + ((size_t)c * 3072 + gt) * 2;
            const float er = p[0], ei = p[1];
            p[0] = xr; p[1] = xi;
            const float nr = ar * xr - ai * xi + er, ni = ar * xi + ai * xr + ei;
            xr = nr; xi = ni;
        }
    } else if (gt < 3072 + 768) {
        const int ch = gt - 3072;
        float* lp = (float*)(wsp(a) + WS_LRUP); float* lh = (float*)(wsp(a) + WS_LRUH);
        float h = 0.f;
#pragma unroll 8
        for (int c = 0; c < LRU_NCH; ++c) {
            const float P = lp[(size_t)c * 768 + ch], H = lh[(size_t)c * 768 + ch];
            lh[(size_t)c * 768 + ch] = h;
            h = P * h + H;
        }
    }
}

__device__ void phase_ffn_act(const Args& a, int l) {
    const bf16_t* up = (const bf16_t*)(wsp(a) + WS_UP);
    bf16_t* act = (bf16_t*)(wsp(a) + WS_ACT);
    const int total = (DFF / 8) * (LSEQ / 16);
    for (int it = blockIdx.x * 512 + tidx(); it < total; it += gridDim.x * 512) {
        const int cg8 = it % (DFF / 8), run = it / (DFF / 8);
        const int c0 = cg8 * 8, t0 = run * 16;
        float w0[8], w1[8], w2[8], cb[8];
#pragma unroll
        for (int e = 0; e < 8; ++e) { w0[e] = inp(a, I_FCW)[(l * 3 + 0) * DFF + c0 + e]; w1[e] = inp(a, I_FCW)[(l * 3 + 1) * DFF + c0 + e]; w2[e] = inp(a, I_FCW)[(l * 3 + 2) * DFF + c0 + e]; cb[e] = inp(a, I_FCB)[l * DFF + c0 + e]; }
        u32x4 g2 = {0u, 0u, 0u, 0u}, g1 = {0u, 0u, 0u, 0u};
        if (t0 > 0) { g2 = *(const u32x4*)(up + (size_t)(t0 - 2) * 6144 + DFF + c0); g1 = *(const u32x4*)(up + (size_t)(t0 - 1) * 6144 + DFF + c0); }
        for (int tb = 0; tb < 16; tb += 4) {
            u32x4 gq[4], vq[4];
#pragma unroll
            for (int q = 0; q < 4; ++q) { gq[q] = *(const u32x4*)(up + (size_t)(t0 + tb + q) * 6144 + DFF + c0); vq[q] = *(const u32x4*)(up + (size_t)(t0 + tb + q) * 6144 + c0); }
#pragma unroll
            for (int q = 0; q < 4; ++q) {
                const u32x4 g0 = gq[q], vv = vq[q];
                u32x4 rr;
#pragma unroll
                for (int e = 0; e < 4; ++e) {
                    const float glo = cb[2 * e] + w0[2 * e] * bflo(g2[e]) + w1[2 * e] * bflo(g1[e]) + w2[2 * e] * bflo(g0[e]);
                    const float ghi = cb[2 * e + 1] + w0[2 * e + 1] * bfhi(g2[e]) + w1[2 * e + 1] * bfhi(g1[e]) + w2[2 * e + 1] * bfhi(g0[e]);
                    rr[e] = cvt_pk_bf16(bflo(vv[e]) * gelu_tanh(glo), bfhi(vv[e]) * gelu_tanh(ghi));
                }
                *(u32x4*)(act + (size_t)(t0 + tb + q) * DFF + c0) = rr;
                g2 = g1; g1 = g0;
            }
        }
    }
}


#define XB_TMO      128
#define XB_XCNT(j)  (256  + 64 * (j))
#define XB_XSUB(j)  (1280 + 64 * (j))
#define XB_XGEN(j)  (2304 + 64 * (j))
#define XB_TOP      3328
#define XB_TOPGEN   3392
#define XCD_BAR_WORDS 3456
#define XB_SPIN_CAP (1u << 18)
#define LAS __attribute__((address_space(3)))
__device__ __forceinline__ unsigned xb_ld(unsigned* p)              { return __hip_atomic_load(p, __ATOMIC_RELAXED, __HIP_MEMORY_SCOPE_AGENT); }
__device__ __forceinline__ unsigned xb_add(unsigned* p, unsigned v) { return __hip_atomic_fetch_add(p, v, __ATOMIC_RELAXED, __HIP_MEMORY_SCOPE_AGENT); }
__device__ __forceinline__ unsigned xb_xcc_id() { return (unsigned)__builtin_amdgcn_s_getreg((3 << 11) | 20) & 0xFu; }
#define XB_SPIN(cond, bar) do { unsigned _sp = 0; while (cond) { __builtin_amdgcn_s_sleep(1); \
    if ((++_sp & 255u) == 0u) { if (xb_ld(&(bar)[XB_TMO])) break; if (_sp > XB_SPIN_CAP) { atomicAdd(&(bar)[XB_TMO], 1u); break; } } } } while (0)
struct XcdBarrier { unsigned* bar; unsigned x; volatile LAS unsigned* st; };
__device__ __forceinline__ XcdBarrier xcd_barrier_post(unsigned* bar, volatile LAS unsigned* st) {
    XcdBarrier b; b.bar = bar; b.x = xb_xcc_id(); b.st = st;
    if (threadIdx.x == 0) (void)xb_add(&bar[XB_XCNT(b.x)], 1u);
    return b;
}
__device__ __forceinline__ void xcd_barrier_complete(unsigned* bar, unsigned x, unsigned& nloc, unsigned& nx) {
    const unsigned G = gridDim.x * gridDim.y * gridDim.z;
    unsigned sum, cnt, mine, sp = 0u;
    for (;;) {
        sum = 0u; cnt = 0u; mine = 0u;
#pragma unroll
        for (unsigned j = 0; j < 16; ++j) { const unsigned c = xb_ld(&bar[XB_XCNT(j)]); sum += c; cnt += (c > 0u) ? 1u : 0u; mine = (j == x) ? c : mine; }
        if (sum == G) break;
        __builtin_amdgcn_s_sleep(1);
        if ((++sp & 255u) == 0u) { if (xb_ld(&bar[XB_TMO])) break; if (sp > XB_SPIN_CAP) { atomicAdd(&bar[XB_TMO], 1u); break; } }
    }
    nloc = mine > 0u ? mine : 1u; nx = cnt > 0u ? cnt : 1u;
}
__device__ __forceinline__ void xcd_barrier(const XcdBarrier& b) {
    asm volatile("s_waitcnt vmcnt(0)" ::: "memory");
    __syncthreads();
    if (threadIdx.x == 0) {
        unsigned* bar = b.bar;
        __builtin_amdgcn_s_waitcnt(0);
        unsigned nloc = b.st[0], nx = b.st[1];
        if (nloc == 0u) { xcd_barrier_complete(bar, b.x, nloc, nx); b.st[0] = nloc; b.st[1] = nx; }
        const unsigned old = xb_add(&bar[XB_XSUB(b.x)], 1u);
        const unsigned gen = old / nloc;
        if (old + 1u == (gen + 1u) * nloc) {
            __builtin_amdgcn_fence(__ATOMIC_RELEASE, "agent");
            asm volatile("s_waitcnt vmcnt(0)" ::: "memory");
            const unsigned og = xb_add(&bar[XB_TOP], 1u);
            const unsigned tg = og / nx;
            if (og + 1u == (tg + 1u) * nx) xb_add(&bar[XB_TOPGEN], 1u);
            else XB_SPIN(xb_ld(&bar[XB_TOPGEN]) == tg, bar);
            __builtin_amdgcn_fence(__ATOMIC_ACQUIRE, "agent");
            xb_add(&bar[XB_XGEN(b.x)], 1u);
            asm volatile("s_waitcnt vmcnt(0)" ::: "memory");
        } else {
            XB_SPIN(xb_ld(&bar[XB_XGEN(b.x)]) == gen, bar);
            __builtin_amdgcn_fence(__ATOMIC_ACQUIRE, "agent");
            asm volatile("s_waitcnt vmcnt(0)" ::: "memory");
        }
    }
    __syncthreads();
}

constexpr int PH_PER_BATCH = 16, PH_PER_LAYER = 2 + 2 * PH_PER_BATCH, PH_TOTAL = 2 * PH_PER_LAYER;


__global__ void __launch_bounds__(512, 2) mega_fwd(Args a) {
    extern __shared__ __attribute__((aligned(16))) unsigned char shm[];
    cg::grid_group grid = cg::this_grid();
    if (a.ph_lo < 0) grid.sync();
    if (threadIdx.x < 4) ((volatile LAS unsigned*)(shm + 135168))[threadIdx.x] = 0u;
    __syncthreads();
    XcdBarrier xbar = xcd_barrier_post((unsigned*)(GAS unsigned*)(a.ws + WS_BAR), (volatile LAS unsigned*)(shm + 135168));
    bool redo = false;
    for (int ph = a.ph_lo; ph < a.ph_hi; ++ph) {
        unsigned char* ws = wsp(a);
        const int l = ph / PH_PER_LAYER, r = ph % PH_PER_LAYER;
        const int b = (r >= 2) ? (r - 2) / PH_PER_BATCH : 0, s = (r >= 2) ? (r - 2) % PH_PER_BATCH : (r == 0 ? 100 : 101);
        if ((s >= 7 && s <= 9) || s == 101 || (s == 0 && b == 1)) continue;
        const size_t boff = (size_t)b * LSEQ * 1024;
        pg8::Gemm g; g.A = nullptr; g.Bt = nullptr; g.M = LSEQ; g.N = 1024; g.K = 1024;
        EpiUni E; E.mode = -1; E.O = nullptr; E.ld = 1024; E.zG = (const bf16_t*)(ws + WS_ZG); E.goff = 0; E.O2 = nullptr;
        switch (s) {
        case 1: g.A = (const bf16_t*)(ws + WS_HB); g.Bt = (const bf16_t*)(ws + WS_WINT); g.N = NIN; g.K = 1024; E.mode = M_WIN; E.O = ws + WS_ZA; E.O2 = (bf16_t*)(ws + WS_ZG); break;
        case 5: g.A = (const bf16_t*)(ws + WS_GY); g.Bt = (const bf16_t*)(ws + WS_GLUT); g.N = 1536; g.K = 768; E.mode = M_GLU; E.O = (bf16_t*)(ws + WS_YCAT) + YC_C; break;
        case 6: g.A = (const bf16_t*)(ws + WS_YCAT); g.Bt = (const bf16_t*)(ws + WS_PAT); g.K = YCW; E.mode = M_MERGE; E.O = ws + WS_MB; break;
        case 10: g.A = (const bf16_t*)(ws + WS_MB); g.Bt = (const bf16_t*)(ws + WS_WOUTT); g.K = 1024; E.mode = M_BF16; E.O = ws + WS_YOUT1; E.ld = 1024; break;
        case 12: g.A = (const bf16_t*)(ws + WS_HB); g.Bt = (const bf16_t*)(ws + WS_UPT); g.N = 6144; g.K = 1024; E.mode = M_BF16; E.O = ws + WS_UP; E.ld = 6144; break;
        case 14: g.A = (const bf16_t*)(ws + WS_ACT); g.Bt = (const bf16_t*)(ws + WS_DOWNT); g.K = 3072; E.mode = M_BF16; E.O = ws + WS_YOUT2; E.ld = 1024; break;
        default: break;
        }
        const int sidx = (s >= 100) ? s - 84 : s;
        const int reps = ((DUPMASK >> sidx) & 1) ? 2 : 1;
        for (int rep = 0; rep < reps; ++rep) {
        if (rep > 0) xcd_barrier(xbar);
        if (E.mode >= 0) {
            const int ngemm = (s == 1 && b == 0) ? 2 : 1;
            for (int gi = 0; gi < ngemm; ++gi) {
                pg8::StaticOrder S;
                if (gi == 0) S.init(g.M, g.N, (int)gridDim.x, (int)blockIdx.x);
                else {
                    g.A = (const bf16_t*)(ws + WS_MEMN); g.Bt = (const bf16_t*)(ws + WS_WKVT); g.M = 512; g.N = 1536; g.K = 1024;
                    E.mode = M_BF16; E.O = ws + WS_KVM; E.ld = 1536;
                    const int c2 = (int)blockIdx.x - 64;
                    S.init(512, 1536, 12, (c2 >= 0 && c2 < 12) ? c2 : (1 << 24));
                }
                if (PH_ON(1)) pg8::gemm_phase<EpiUni>((PG8_LAS unsigned char*)shm, g, S, E);
            }
            if (s == 5) { const int h = (int)gridDim.x / 2; if ((int)blockIdx.x >= h) for (int t = (int)blockIdx.x - h; t < N_COMB_TILES; t += (int)gridDim.x - h) combine_tile(a, t); }
        }
        if (E.mode < 0 || s == 0) {
            const float* xin = (l == 0 ? inp(a, I_X) : (const float*)outp(a)) + boff;
            float* xout = outp(a) + boff;
            if (s == 100) { if (PH_ON(100)) phase_convert(a, l, (float*)shm); }
            else if (s == 0) { if (PH_ON(0)) phase_prenorm(xin, inp(a, I_GMIXPRE) + l * 1024, (bf16_t*)(ws + WS_HB)); }
            else if (s == 2) { if (PH_ON(2)) phase_mix1(a, l, b, shm); }
            else if (s == 3) { if (PH_ON(3)) phase_mixB(a, l, b, shm); }
            else if (s == 4) { if (PH_ON(4)) phase_mix2(a, l, shm); }
            else if (s == 11) { if (PH_ON(11)) phase_postnorm<true>(xin, (const bf16_t*)(ws + WS_YOUT1), inp(a, I_GMIXPOST) + l * 1024, xout, inp(a, I_GMLPPRE) + l * 1024, (bf16_t*)(ws + WS_HB)); }
            else if (s == 13) { if (PH_ON(13)) phase_ffn_act(a, l); }
            else if (s == 15) {
                if (PH_ON(15)) phase_postnorm<false>(xout, (const bf16_t*)(ws + WS_YOUT2), inp(a, I_GMLPPOST) + l * 1024, xout, nullptr, nullptr);
                if (b == 0) {
                    const float* xin1 = (l == 0 ? inp(a, I_X) : (const float*)outp(a)) + (size_t)LSEQ * 1024;
                    phase_prenorm(xin1, inp(a, I_GMIXPRE) + l * 1024, (bf16_t*)(ws + WS_HB));
                }
            }
        }
        }
        if (ph + 1 < a.ph_hi) xcd_barrier(xbar);
#ifdef DUPMERGE
        if (s == 6 && !redo) { redo = true; ph -= 1; } else if (s == 10) redo = false;
#endif
    }
}

extern "C" void kernel_launch(void* const* d_in, const int* in_sizes, int n_in, void* d_out, int out_size, void* d_ws, size_t ws_size, hipStream_t stream) {
    static int grid = 0;
    if (grid == 0) {
        if (n_in != 34 || ws_size < WS_END) { fprintf(stderr, "kernel_launch: unexpected n_in %d or ws_size %zu (< %zu)\n", n_in, ws_size, (size_t)WS_END); grid = -1; return; }
        int dev = 0, cus = 0, per_cu = 0;
        hipGetDevice(&dev);
        hipDeviceGetAttribute(&cus, hipDeviceAttributeMultiprocessorCount, dev);
        hipFuncSetAttribute((const void*)mega_fwd, hipFuncAttributeMaxDynamicSharedMemorySize, LDS_BYTES);
        hipOccupancyMaxActiveBlocksPerMultiprocessor(&per_cu, (const void*)mega_fwd, 512, LDS_BYTES);
        if (per_cu < 1) per_cu = 1;
        grid = cus * per_cu;
        (void)hipGetLastError();
    }
    if (grid < 0) return;
    Args a{};
    for (int i = 0; i < 34; ++i) a.in[i] = (const float*)d_in[i];
    a.out = (float*)d_out; a.ws = (unsigned char*)d_ws;
    (void)hipMemsetAsync((unsigned char*)d_ws + WS_BAR, 0, 16384, stream);
#if MK_SINGLE
    a.ph_lo = 0; a.ph_hi = PH_TOTAL;
    void* args[] = {&a};
    hipError_t e = hipLaunchCooperativeKernel((const void*)mega_fwd, dim3(grid), dim3(512), args, LDS_BYTES, stream);
    if (e != hipSuccess) fprintf(stderr, "cooperative launch failed: %s (grid %d)\n", hipGetErrorString(e), grid);
#else
    for (int ph = 0; ph < PH_TOTAL; ++ph) {
        a.ph_lo = ph; a.ph_hi = ph + 1;
        hipLaunchKernelGGL(mega_fwd, dim3(grid), dim3(512), LDS_BYTES, stream, a);
    }
#endif
}
```

```cpp
#include <hip/hip_runtime.h>
#include <hip/hip_cooperative_groups.h>
#include <cstdio>
namespace cg = cooperative_groups;

#ifndef ONLY_S
#define ONLY_S -1
#endif
#ifndef PHMASK
#define PHMASK 0xFFFFF
#endif
#define PH_ON(k) ((ONLY_S < 0 || ONLY_S == (k)) && ((PHMASK >> ((k) >= 100 ? (k) - 84 : (k))) & 1))
#ifndef DUPMASK
#define DUPMASK 0
#endif
#ifndef DUPMIX
#define DUPMIX 0
#endif
#define DM(k) for (int _rp = 0; _rp < 1 + ((DUPMIX >> (k)) & 1); ++_rp)
#ifndef MK_SINGLE
#define MK_SINGLE 1
#endif

constexpr int LSEQ = 16384, DM = 1024, NBATCH = 2, NIN = 9472, MEMLEN = 256;
constexpr int ZAW = 5376, ZGW = 4160;
constexpr int OFF_XA = 0, OFF_GA = 768, OFF_Q = 1536, OFF_K = 2304, OFF_V = 3072, OFF_US = 3840, OFF_XQ = 4608;
constexpr int DFF = 3072;
constexpr int S5_LC = 128, S5_NCH = LSEQ / S5_LC;
constexpr int LRU_LC = 128, LRU_NCH = LSEQ / LRU_LC;
constexpr float EPS = 1e-6f;
constexpr int LDS_BYTES = 135168 + 16;

typedef unsigned short bf16_t;
typedef short bf16x8 __attribute__((ext_vector_type(8)));
typedef float f32x4 __attribute__((ext_vector_type(4)));
typedef unsigned u32x4 __attribute__((ext_vector_type(4)));
typedef unsigned u32x2 __attribute__((ext_vector_type(2)));

__device__ __forceinline__ unsigned cvt_pk_bf16(float lo, float hi) { unsigned r; asm volatile("v_cvt_pk_bf16_f32 %0, %1, %2" : "=v"(r) : "v"(lo), "v"(hi)); return r; }
__device__ __forceinline__ bf16_t f2bf(float f) { unsigned u = __float_as_uint(f); u += 0x7FFFu + ((u >> 16) & 1u); return (bf16_t)(u >> 16); }
__device__ __forceinline__ float bf2f(bf16_t b) { return __uint_as_float(((unsigned)b) << 16); }
__device__ __forceinline__ float bflo(unsigned w) { return __uint_as_float(w << 16); }
__device__ __forceinline__ float bfhi(unsigned w) { return __uint_as_float(w & 0xffff0000u); }
__device__ __forceinline__ float fexp(float x) { return __builtin_amdgcn_exp2f(x * 1.4426950408889634f); }
__device__ __forceinline__ float sigmoidf_(float x) { return __builtin_amdgcn_rcpf(1.0f + fexp(-x)); }
__device__ __forceinline__ float gelu_tanh(float x) { const float u = -2.3022081302f * (x + 0.044715f * x * x * x); return x * __builtin_amdgcn_rcpf(1.0f + __builtin_amdgcn_exp2f(u)); }

struct Args {
    const float* in[34];
    float* out;
    unsigned char* ws;
    int ph_lo, ph_hi;
};
enum { I_X = 0, I_MEM, I_GMIXPRE, I_GMIXPOST, I_GMEM, I_GMLPPRE, I_GMLPPOST, I_WIN, I_LCW, I_LCB, I_LWA, I_LBA, I_LWX, I_LBX, I_LLAM,
       I_SARE, I_SAIM, I_SLOGDT, I_SBRE, I_SBIM, I_SCRE, I_SCIM, I_SD, I_SGLU, I_MEMWKV, I_PA, I_PB, I_PC, I_PX, I_WOUT, I_FUP, I_FCW, I_FCB, I_FDOWN };

__device__ __forceinline__ int opq_s(int v) { asm volatile("" : "+s"(v)); return v; }
__device__ __forceinline__ int tidx() { int v = (int)threadIdx.x; asm volatile("" : "+v"(v)); return v; }
#define GAS __attribute__((address_space(1)))
__device__ __forceinline__ size_t opq0() { size_t z = 0; asm volatile("" : "+s"(z)); return z; }
__device__ __forceinline__ unsigned char* wsp(const Args& a) { return a.ws + opq0(); }
__device__ __forceinline__ float* outp(const Args& a) { return a.out + opq0(); }
__device__ __forceinline__ const float* inp(const Args& a, int k) { return a.in[k] + opq0(); }
constexpr size_t al256(size_t x) { return (x + 255) & ~(size_t)255; }
constexpr size_t WS_WINT = 0;
constexpr size_t WS_GLUT = WS_WINT + (size_t)NIN * 1024 * 2;
constexpr size_t WS_WKVT = WS_GLUT + (size_t)1536 * 768 * 2;
constexpr size_t WS_PAT = WS_WKVT + (size_t)1536 * 1024 * 2;
constexpr size_t WS_PBT = WS_PAT + (size_t)1024 * 768 * 2;
constexpr size_t WS_PCT = WS_PBT + (size_t)1024 * 256 * 2;
constexpr size_t WS_PXT = WS_PCT + (size_t)1024 * 768 * 2;
constexpr size_t WS_WOUTT = WS_PXT + (size_t)1024 * 768 * 2;
constexpr size_t WS_UPT = WS_WOUTT + (size_t)1024 * 1024 * 2;
constexpr size_t WS_DOWNT = WS_UPT + (size_t)6144 * 1024 * 2;
constexpr size_t WS_WAT = WS_DOWNT + (size_t)1024 * 3072 * 2;
constexpr size_t WS_WXT = WS_WAT + (size_t)12 * 4096 * 2;
constexpr size_t WS_ABAR = WS_WXT + (size_t)12 * 4096 * 2;
constexpr size_t WS_ABARL = WS_ABAR + (size_t)48 * 64 * 2 * 4;
constexpr size_t WS_BBART = WS_ABARL + (size_t)48 * 64 * 2 * 4;
constexpr size_t WS_CMAT = WS_BBART + (size_t)48 * 128 * 16 * 2;
constexpr size_t WS_MEMN = WS_CMAT + (size_t)48 * 16 * 128 * 2;
constexpr size_t WS_KVM = WS_MEMN + (size_t)512 * 1024 * 2;
constexpr size_t WS_S5C = WS_KVM + (size_t)512 * 1536 * 2;
constexpr size_t WS_LRUP = WS_S5C + (size_t)S5_NCH * 48 * 64 * 2 * 4;
constexpr size_t WS_LRUH = WS_LRUP + (size_t)LRU_NCH * 768 * 4;
constexpr size_t WS_HB = al256(WS_LRUH + (size_t)LRU_NCH * 768 * 4);
constexpr size_t WS_Z = WS_HB + (size_t)LSEQ * 1024 * 2;
constexpr size_t WS_ZA = WS_Z;
constexpr size_t WS_ZG = WS_ZA + (size_t)LSEQ * ZAW * 2;
constexpr size_t WS_UP = WS_Z;
constexpr size_t WS_ACT = WS_UP + (size_t)LSEQ * 6144 * 2;
constexpr size_t WS_MB = WS_ZA;
constexpr size_t WS_YOUT1 = WS_MB + (size_t)LSEQ * 1024 * 2;
constexpr size_t WS_Y = WS_ZG + (size_t)LSEQ * ZGW * 2;
constexpr size_t WS_OATT = WS_HB;
constexpr size_t WS_LSE = WS_Y;
constexpr size_t WS_GY = WS_LSE + (size_t)LSEQ * 12 * 4;
constexpr size_t WS_YCAT = WS_GY + (size_t)LSEQ * 768 * 2;
constexpr int YCW = 2560, YC_A = 0, YC_B = 768, YC_C = 1024, YC_X = 1792;
constexpr size_t WS_YOUT2 = WS_Y;
constexpr size_t WS_BAR = WS_YCAT + (size_t)LSEQ * YCW * 2;
constexpr size_t WS_END = WS_BAR + 16384;
static_assert(WS_ACT + (size_t)LSEQ * 3072 * 2 <= WS_Y, "up/act alias overflow");
static_assert(WS_YOUT1 + (size_t)LSEQ * 1024 * 4 <= WS_ZG, "mb/yout alias overflow");
static_assert(WS_YOUT2 + (size_t)LSEQ * 1024 * 4 <= WS_END, "yout2 alias overflow");
static_assert(WS_END <= (size_t)512 * 1024 * 1024, "workspace too large");

namespace pg8 {
#define PG8_LAS __attribute__((address_space(3)))
constexpr int BM = 256, BK = 64, HALF = 128, HTB = HALF * BK * 2, STAGE_BYTES = 8 * HTB, NXCD = 8, WGM = 4;
__host__ __device__ __forceinline__ int lds_byte(int r, int c) { const int st = (r >> 4) * 2 + (c >> 5), rr = r & 15, cc = c & 31, ob = rr * 64 + cc * 2; return st * 1024 + (ob ^ (((ob >> 9) & 1) << 5)); }
__host__ __device__ __forceinline__ void stage_rc(int b, int& R, int& C) { const int st = b / 1024, sb = b % 1024, swz = sb ^ (((sb >> 9) & 1) << 5); R = (st >> 1) * 16 + swz / 64; C = (st & 1) * 32 + (swz % 64) / 2; }
__host__ __device__ __forceinline__ int perm32(int rho) { const int n = rho >> 4, i = rho & 15; return 8 * (i >> 2) + 4 * n + (i & 3); }
struct Unit { int pm, pn; };
struct Gemm { const bf16_t* A; const bf16_t* Bt; int M, N, K; };
struct StaticOrder {
    int nM, nN, nwg, G, c;
    __device__ void init(int M, int N, int G_, int c_) { nM = M / BM; nN = N / BM; nwg = nM * nN; G = G_; c = c_; }
    __device__ bool next(int i, Unit& u) const {
        const long L = (long)i * G + c; if (L >= nwg) return false;
        int wgid = (int)L; { const int q = nwg / NXCD, r = nwg % NXCD, xcd = wgid % NXCD, off = wgid / NXCD; wgid = (xcd < r ? xcd * (q + 1) : r * (q + 1) + (xcd - r) * q) + off; }
        const int nig = WGM * nN, gid = wgid / nig, fm = gid * WGM, gsz = (nM - fm) < WGM ? (nM - fm) : WGM;
        u.pm = fm + ((wgid % nig) % gsz); u.pn = (wgid % nig) / gsz; return true;
    }
};
template <class Epi>
__device__ __forceinline__ void gemm_phase(PG8_LAS unsigned char* lds, const Gemm g, const StaticOrder& S, const Epi& E) {
    const int tid = tidx(), wid = __builtin_amdgcn_readfirstlane(tid >> 6), lane = tid & 63, wr = wid >> 2, wc = wid & 3, fr = lane & 15, fq = lane >> 4;
    const int K = g.K, nt = K / BK;
    unsigned voffA[2], voffB[2];
#pragma unroll
    for (int i = 0; i < 2; ++i) { int R, C; stage_rc(tid * 16 + i * 8192, R, C); const int Rb = (R & ~31) + perm32(R & 31); voffA[i] = (unsigned)(R * K + C) * 2u; voffB[i] = (unsigned)(Rb * K + C) * 2u; }
    const size_t kstep = (size_t)(BK * 2);
    const size_t hstep = (size_t)HALF * K * 2;
    const size_t tstep = 2 * hstep;
    const unsigned ldsw = (unsigned)wid * 1024u;
    const int aoff = lds_byte(wr * 64 + fr, fq * 8), boff = lds_byte(wc * 32 + fr, fq * 8);
#define PG8_SA(b, h) (((b) * 2 + (h)) * HTB)
#define PG8_SB(b, h) ((4 + (b) * 2 + (h)) * HTB)
#define PG8_STAGE(bufoff, gbase, voff) do { _Pragma("unroll") for (int _i = 0; _i < 2; ++_i) \
        __builtin_amdgcn_global_load_lds((const unsigned*)((const char*)(gbase) + (voff)[_i]), (PG8_LAS unsigned*)(lds + (bufoff) + ldsw + _i * 8192), 16, 0, 0); } while (0)
#define PG8_LDA(dst, b, h) do { _Pragma("unroll") for (int m = 0; m < 4; ++m) _Pragma("unroll") for (int k = 0; k < 2; ++k) dst[m][k] = *(const PG8_LAS bf16x8*)(lds + PG8_SA(b, h) + aoff + m * 2048 + k * 1024); } while (0)
#define PG8_LDB(dst, b, h) do { _Pragma("unroll") for (int n = 0; n < 2; ++n) _Pragma("unroll") for (int k = 0; k < 2; ++k) dst[n][k] = *(const PG8_LAS bf16x8*)(lds + PG8_SB(b, h) + boff + n * 2048 + k * 1024); } while (0)
#define PG8_MMA(ai, bj, At, Bt) do { __builtin_amdgcn_s_setprio(1); _Pragma("unroll") for (int m = 0; m < 4; ++m) _Pragma("unroll") for (int n = 0; n < 2; ++n) _Pragma("unroll") for (int k = 0; k < 2; ++k) \
        acc[ai][bj][m][n] = __builtin_amdgcn_mfma_f32_16x16x32_bf16(Bt[n][k], At[m][k], acc[ai][bj][m][n], 0, 0, 0); __builtin_amdgcn_s_setprio(0); } while (0)
#define PG8_WAIT_V(n) asm volatile("s_waitcnt vmcnt(" #n ")" ::: "memory")
#define PG8_WAIT_L(n) asm volatile("s_waitcnt lgkmcnt(" #n ")" ::: "memory")
#define PG8_BAR __builtin_amdgcn_s_barrier()
#define PG8_SCHED __builtin_amdgcn_sched_barrier(0)
    Unit cur, nxt; int ui = 0;
    if (!S.next(0, cur)) return;
    f32x4 acc[2][2][4][2];
#pragma unroll
    for (int a = 0; a < 2; ++a)
#pragma unroll
        for (int b = 0; b < 2; ++b)
#pragma unroll
            for (int m = 0; m < 4; ++m)
#pragma unroll
                for (int n = 0; n < 2; ++n) acc[a][b][m][n] = (f32x4){0.f, 0.f, 0.f, 0.f};
    bf16x8 At[4][2], B0[2][2], B1[2][2];
    const char* cA = (const char*)g.A + (size_t)cur.pm * tstep; const char* cB = (const char*)g.Bt + (size_t)cur.pn * tstep;
    PG8_STAGE(PG8_SB(0, 0), cB, voffB); PG8_STAGE(PG8_SB(0, 1), cB + hstep, voffB); PG8_STAGE(PG8_SA(0, 0), cA, voffA); PG8_STAGE(PG8_SA(0, 1), cA + hstep, voffA);
    if (wr == 1) PG8_BAR;
    PG8_WAIT_V(2); PG8_BAR;
    PG8_STAGE(PG8_SB(1, 0), cB + kstep, voffB); PG8_STAGE(PG8_SA(1, 0), cA + kstep, voffA); PG8_STAGE(PG8_SB(1, 1), cB + hstep + kstep, voffB);
    PG8_WAIT_V(6); PG8_BAR;
    for (;;) {
        const bool has_next = S.next(ui + 1, nxt);
        const char* nA = has_next ? (const char*)g.A + (size_t)nxt.pm * tstep : cA; const char* nB = has_next ? (const char*)g.Bt + (size_t)nxt.pn * tstep : cB;
        for (int t = 0; t < nt; t += 2) {
            const bool last = (t == nt - 2);
            E.mid(acc, cur, t, wr, wc, fr, fq);
            const char* a1 = cA + (size_t)(t + 1) * kstep;
            const char* a2 = last ? nA : cA + (size_t)(t + 2) * kstep; const char* b2 = last ? nB : cB + (size_t)(t + 2) * kstep;
            const char* a3 = a2 + kstep; const char* b3 = b2 + kstep;
            PG8_LDB(B0, 0, 0); PG8_LDB(B1, 0, 1); PG8_SCHED; PG8_LDA(At, 0, 0); PG8_STAGE(PG8_SA(1, 1), a1 + hstep, voffA);
            PG8_WAIT_V(8); PG8_WAIT_L(0); PG8_BAR; PG8_MMA(0, 0, At, B0); PG8_MMA(0, 1, At, B1); PG8_BAR; PG8_SCHED;
            PG8_LDA(At, 0, 1); PG8_STAGE(PG8_SB(0, 0), b2, voffB); PG8_STAGE(PG8_SB(0, 1), b2 + hstep, voffB); PG8_STAGE(PG8_SA(0, 0), a2, voffA);
            PG8_WAIT_V(8); PG8_WAIT_L(0); PG8_BAR; PG8_MMA(1, 0, At, B0); PG8_MMA(1, 1, At, B1); PG8_BAR; PG8_SCHED;
            PG8_LDB(B0, 1, 0); PG8_LDB(B1, 1, 1); PG8_SCHED; PG8_LDA(At, 1, 0); PG8_STAGE(PG8_SA(0, 1), a2 + hstep, voffA);
            PG8_WAIT_V(8); PG8_WAIT_L(0); PG8_BAR; PG8_MMA(0, 0, At, B0); PG8_MMA(0, 1, At, B1); PG8_BAR; PG8_SCHED;
            PG8_LDA(At, 1, 1); PG8_STAGE(PG8_SB(1, 0), b3, voffB); PG8_STAGE(PG8_SB(1, 1), b3 + hstep, voffB); PG8_STAGE(PG8_SA(1, 0), a3, voffA);
            PG8_WAIT_V(8); PG8_WAIT_L(0); PG8_BAR; PG8_MMA(1, 0, At, B0); PG8_MMA(1, 1, At, B1); PG8_BAR; PG8_SCHED;
        }
        if (wr == 0) PG8_BAR;
        E(acc, cur, wr, wc, fr, fq);
        if (!has_next) break;
#pragma unroll
        for (int a = 0; a < 2; ++a)
#pragma unroll
            for (int b = 0; b < 2; ++b)
#pragma unroll
                for (int m = 0; m < 4; ++m)
#pragma unroll
                    for (int n = 0; n < 2; ++n) acc[a][b][m][n] = (f32x4){0.f, 0.f, 0.f, 0.f};
        cur = nxt; cA = nA; cB = nB; ++ui;
        if (wr == 1) PG8_BAR;
    }
    PG8_WAIT_V(0);
    PG8_BAR;
#undef PG8_SA
#undef PG8_SB
#undef PG8_STAGE
#undef PG8_LDA
#undef PG8_LDB
#undef PG8_MMA
#undef PG8_WAIT_V
#undef PG8_WAIT_L
#undef PG8_BAR
#undef PG8_SCHED
}
}

typedef f32x4 AccT[2][2][4][2];

__device__ __forceinline__ u32x4 pack8(const f32x4& a, const f32x4& b) { u32x4 w; w[0] = cvt_pk_bf16(a[0], a[1]); w[1] = cvt_pk_bf16(a[2], a[3]); w[2] = cvt_pk_bf16(b[0], b[1]); w[3] = cvt_pk_bf16(b[2], b[3]); return w; }
struct EpiWin {
    bf16_t* zA; bf16_t* zG;
    __device__ __forceinline__ void operator()(const AccT& acc, const pg8::Unit& u, int wr, int wc, int fr, int fq) const {
        const int row0 = u.pm * 256 + wr * 64 + fr;
        const int pn = u.pn;
        bf16_t* base; int ld, colt, mode;
        if (pn < 21) { base = zA; ld = ZAW; colt = pn * 256; mode = (pn >= 3 && pn < 6) ? 1 : 0; }
        else { base = zG; ld = ZGW; colt = (pn - 21) * 256; mode = 2; }
        const int col0 = colt + wc * 32 + 8 * fq;
#pragma unroll
        for (int ai = 0; ai < 2; ++ai)
#pragma unroll
            for (int m = 0; m < 4; ++m) {
                bf16_t* rowp = base + (size_t)(row0 + ai * 128 + m * 16) * ld + col0;
#pragma unroll
                for (int bj = 0; bj < 2; ++bj) {
                    f32x4 v0 = acc[ai][bj][m][0], v1 = acc[ai][bj][m][1];
                    if (mode == 1) {
#pragma unroll
                        for (int i = 0; i < 4; ++i) { v0[i] = gelu_tanh(v0[i]); v1[i] = gelu_tanh(v1[i]); }
                    } else if (mode == 2) {
#pragma unroll
                        for (int i = 0; i < 4; ++i) { v0[i] = sigmoidf_(v0[i]); v1[i] = sigmoidf_(v1[i]); }
                    }
                    *(u32x4*)(rowp + bj * 128) = pack8(v0, v1);
                }
            }
    }
};
struct EpiBf16 {
    bf16_t* O; int ld;
    __device__ __forceinline__ void operator()(const AccT& acc, const pg8::Unit& u, int wr, int wc, int fr, int fq) const {
        const int row0 = u.pm * 256 + wr * 64 + fr, col0 = u.pn * 256 + wc * 32 + 8 * fq;
#pragma unroll
        for (int ai = 0; ai < 2; ++ai)
#pragma unroll
            for (int m = 0; m < 4; ++m) {
                bf16_t* rowp = O + (size_t)(row0 + ai * 128 + m * 16) * ld + col0;
#pragma unroll
                for (int bj = 0; bj < 2; ++bj) *(u32x4*)(rowp + bj * 128) = pack8(acc[ai][bj][m][0], acc[ai][bj][m][1]);
            }
    }
};
struct EpiF32 {
    float* C; int ld;
    __device__ __forceinline__ void operator()(const AccT& acc, const pg8::Unit& u, int wr, int wc, int fr, int fq) const {
        const int row0 = u.pm * 256 + wr * 64 + fr, col0 = u.pn * 256 + wc * 32 + 8 * fq;
#pragma unroll
        for (int ai = 0; ai < 2; ++ai)
#pragma unroll
            for (int m = 0; m < 4; ++m) {
                float* rowp = C + (size_t)(row0 + ai * 128 + m * 16) * ld + col0;
#pragma unroll
                for (int bj = 0; bj < 2; ++bj) { *(f32x4*)(rowp + bj * 128) = acc[ai][bj][m][0]; *(f32x4*)(rowp + bj * 128 + 4) = acc[ai][bj][m][1]; }
            }
    }
};
struct EpiGlu {
    bf16_t* O;
    __device__ __forceinline__ void operator()(const AccT& acc, const pg8::Unit& u, int wr, int wc, int fr, int fq) const {
        const int row0 = u.pm * 256 + wr * 64 + fr, col0 = u.pn * 128 + wc * 32 + 8 * fq;
#pragma unroll
        for (int ai = 0; ai < 2; ++ai)
#pragma unroll
            for (int m = 0; m < 4; ++m) {
                bf16_t* rowp = O + (size_t)(row0 + ai * 128 + m * 16) * YCW + col0;
                f32x4 o0, o1;
#pragma unroll
                for (int i = 0; i < 4; ++i) { o0[i] = acc[ai][0][m][0][i] * sigmoidf_(acc[ai][1][m][0][i]); o1[i] = acc[ai][0][m][1][i] * sigmoidf_(acc[ai][1][m][1][i]); }
                *(u32x4*)(rowp) = pack8(o0, o1);
            }
    }
};
struct EpiMergeF {
    bf16_t* mb; const bf16_t* zG;
    __device__ __forceinline__ void rescale(AccT& acc, const pg8::Unit& u, int b, int wr, int wc, int fr, int fq) const {
        int zz = 0; asm volatile("" : "+v"(zz));
        const int row0 = u.pm * 256 + wr * 64 + fr + zz, col0 = u.pn * 256 + wc * 32 + 8 * fq;
#pragma unroll
        for (int ai = 0; ai < 2; ++ai)
#pragma unroll
            for (int m = 0; m < 4; ++m) {
                const bf16_t* gp = zG + (size_t)(row0 + ai * 128 + m * 16) * ZGW + b * 1024 + col0;
#pragma unroll
                for (int bj = 0; bj < 2; ++bj) {
                    const u32x4 g0 = *(const u32x4*)(gp + bj * 128), g1 = *(const u32x4*)(gp + 1024 + bj * 128);
#pragma unroll
                    for (int e = 0; e < 4; ++e) {
                        const float rlo = bflo(g0[e]) * __builtin_amdgcn_rcpf(bflo(g1[e])), rhi = bfhi(g0[e]) * __builtin_amdgcn_rcpf(bfhi(g1[e]));
                        acc[ai][bj][m][e >> 1][(e & 1) * 2] *= rlo; acc[ai][bj][m][e >> 1][(e & 1) * 2 + 1] *= rhi;
                    }
                }
                __builtin_amdgcn_sched_barrier(0);
            }
    }
    __device__ __forceinline__ void operator()(const AccT& acc, const pg8::Unit& u, int wr, int wc, int fr, int fq) const {
        const int row0 = u.pm * 256 + wr * 64 + fr, col0 = u.pn * 256 + wc * 32 + 8 * fq;
#pragma unroll
        for (int ai = 0; ai < 2; ++ai)
#pragma unroll
            for (int m = 0; m < 4; ++m) {
                const size_t r = (size_t)(row0 + ai * 128 + m * 16);
                bf16_t* rowp = mb + r * 1024 + col0; const bf16_t* gp = zG + r * ZGW + 3072 + col0;
#pragma unroll
                for (int bj = 0; bj < 2; ++bj) {
                    const f32x4 v0 = acc[ai][bj][m][0], v1 = acc[ai][bj][m][1];
                    const u32x4 g = *(const u32x4*)(gp + bj * 128);
                    f32x4 o0, o1;
                    o0[0] = v0[0] * bflo(g[0]); o0[1] = v0[1] * bfhi(g[0]); o0[2] = v0[2] * bflo(g[1]); o0[3] = v0[3] * bfhi(g[1]);
                    o1[0] = v1[0] * bflo(g[2]); o1[1] = v1[1] * bfhi(g[2]); o1[2] = v1[2] * bflo(g[3]); o1[3] = v1[3] * bfhi(g[3]);
                    *(u32x4*)(rowp + bj * 128) = pack8(o0, o1);
                }
            }
    }
};

enum { M_BF16 = 0, M_WIN, M_F32, M_GLU, M_MERGE };
struct EpiUni {
    int mode; void* O; int ld; const bf16_t* zG; int goff; bf16_t* O2;
    __device__ __forceinline__ void mid(AccT& acc, const pg8::Unit& u, int t, int wr, int wc, int fr, int fq) const {
        if (mode == M_MERGE && (t == 12 || t == 16 || t == 28)) { EpiMergeF E; E.mb = (bf16_t*)O; E.zG = zG; E.rescale(acc, u, t == 12 ? 0 : (t == 16 ? 1 : 2), wr, wc, fr, fq); }
    }
    __device__ __forceinline__ void operator()(const AccT& acc, const pg8::Unit& u, int wr, int wc, int fr, int fq) const {
        if (mode == M_F32) { EpiF32 E; E.C = (float*)O; E.ld = ld; E(acc, u, wr, wc, fr, fq); }
        else if (mode == M_GLU) { EpiGlu E; E.O = (bf16_t*)O; E(acc, u, wr, wc, fr, fq); }
        else if (mode == M_MERGE) { EpiMergeF E; E.mb = (bf16_t*)O; E.zG = zG; E(acc, u, wr, wc, fr, fq); }
        else if (mode == M_WIN) { EpiWin E; E.zA = (bf16_t*)O; E.zG = O2; E(acc, u, wr, wc, fr, fq); }
        else { EpiBf16 E; E.O = (bf16_t*)O; E.ld = ld; E(acc, u, wr, wc, fr, fq); }
    }
};

struct ConvJob { const float* s; bf16_t* d; int N, ldd, nbase; bool glu, valid; };
constexpr int CONV_NJ = 12;
__device__ __forceinline__ int conv_total() {
    const int Ks[12] = {1024, 768, 1024, 768, 256, 768, 768, 1024, 1024, 3072, 64, 64};
    const int Ns[12] = {NIN, 1536, 1536, 1024, 1024, 1024, 1024, 1024, 6144, 1024, 64, 64};
    const int nbs[12] = {1, 1, 1, 1, 1, 1, 1, 1, 1, 1, 12, 12};
    int tot = 0;
#pragma unroll
    for (int j = 0; j < CONV_NJ; ++j) tot += (Ks[j] / 64) * (Ns[j] / 64) * nbs[j];
    return tot;
}
__device__ __forceinline__ ConvJob conv_decode(const Args& a, int l, int t, int nconv) {
    const int Ks[12] = {1024, 768, 1024, 768, 256, 768, 768, 1024, 1024, 3072, 64, 64};
    const int Ns[12] = {NIN, 1536, 1536, 1024, 1024, 1024, 1024, 1024, 6144, 1024, 64, 64};
    const int nbs[12] = {1, 1, 1, 1, 1, 1, 1, 1, 1, 1, 12, 12};
    const int srcs[12] = {I_WIN, I_SGLU, I_MEMWKV, I_PA, I_PB, I_PC, I_PX, I_WOUT, I_FUP, I_FDOWN, I_LWA, I_LWX};
    const size_t dsts[12] = {WS_WINT, WS_GLUT, WS_WKVT, WS_PAT, WS_PAT, WS_PAT, WS_PAT, WS_WOUTT, WS_UPT, WS_DOWNT, WS_WAT, WS_WXT};
    const int ldds[12] = {1024, 768, 1024, YCW, YCW, YCW, YCW, 1024, 1024, 3072, 64, 64};
    const int koffs[12] = {0, 0, 0, YC_A, YC_B, YC_C, YC_X, 0, 0, 0, 0, 0};
    ConvJob jb; jb.valid = t < nconv; jb.s = nullptr; jb.d = nullptr; jb.N = 64; jb.ldd = 64; jb.nbase = 0; jb.glu = false;
    if (!jb.valid) return jb;
    int st = 0, j = 0, K = 64, N = 64, nb = 1, si = 0, ldd = 64, koff = 0; size_t dz = 0;
    int acc = 0;
#pragma unroll
    for (int q = 0; q < CONV_NJ; ++q) { const int cnt = (Ks[q] / 64) * (Ns[q] / 64) * nbs[q]; if (t >= acc) { j = q; st = acc; K = Ks[q]; N = Ns[q]; nb = nbs[q]; si = srcs[q]; dz = dsts[q]; ldd = ldds[q]; koff = koffs[q]; } acc += cnt; }
    const int tile = t - st, tk = K / 64, tn = N / 64, per = tk * tn;
    const int bi = tile / per, tt = tile % per, kt = tt / tn, nt = tt % tn;
    jb.s = inp(a, si) + (size_t)l * K * N * nb + (size_t)bi * K * N + (size_t)(kt * 64) * N + nt * 64;
    jb.d = (bf16_t*)(wsp(a) + dz) + (size_t)bi * K * N + koff + kt * 64;
    jb.N = N; jb.ldd = ldd; jb.nbase = nt * 64; jb.glu = (j == 1);
    return jb;
}
__device__ void s5_param_tile(const Args& a, int l, int g, float* lds) {
    const int tid = tidx();
    float* zre = lds; float* zim = lds + 64;
    float* abar = (float*)(wsp(a) + WS_ABAR); float* abarl = (float*)(wsp(a) + WS_ABARL);
    if (tid < 64) {
        const int p = tid;
        const float dt = expf(inp(a, I_SLOGDT)[l * 48 + g]);
        const float lr = inp(a, I_SARE)[(l * 48 + g) * 64 + p], li = inp(a, I_SAIM)[(l * 48 + g) * 64 + p];
        const float mag = expf(lr * dt);
        const float abr = mag * cosf(li * dt), abi = mag * sinf(li * dt);
        const float den = lr * lr + li * li;
        zre[p] = ((abr - 1.0f) * lr + abi * li) / den;
        zim[p] = (abi * lr - (abr - 1.0f) * li) / den;
        abar[(g * 64 + p) * 2] = abr; abar[(g * 64 + p) * 2 + 1] = abi;
        float pr = abr, pi = abi;
        for (int i = 0; i < 7; ++i) { const float nr = pr * pr - pi * pi, ni = 2.0f * pr * pi; pr = nr; pi = ni; }
        abarl[(g * 64 + p) * 2] = pr; abarl[(g * 64 + p) * 2 + 1] = pi;
    }
    __syncthreads();
    bf16_t* bbt = (bf16_t*)(wsp(a) + WS_BBART) + (size_t)g * 128 * 16;
    bf16_t* cm = (bf16_t*)(wsp(a) + WS_CMAT) + (size_t)g * 16 * 128;
    for (int e = tid; e < 1024; e += 512) {
        const int p = e >> 4, h = e & 15;
        const float br = inp(a, I_SBRE)[((size_t)(l * 48 + g) * 64 + p) * 16 + h], bi = inp(a, I_SBIM)[((size_t)(l * 48 + g) * 64 + p) * 16 + h];
        bbt[p * 16 + h] = f2bf(zre[p] * br - zim[p] * bi);
        bbt[(64 + p) * 16 + h] = f2bf(zre[p] * bi + zim[p] * br);
    }
    for (int e = tid; e < 2048; e += 512) {
        const int h = e >> 7, k = e & 127;
        const float v = (k < 64) ? inp(a, I_SCRE)[((size_t)(l * 48 + g) * 16 + h) * 64 + k] : -inp(a, I_SCIM)[((size_t)(l * 48 + g) * 16 + h) * 64 + (k - 64)];
        cm[h * 128 + k] = f2bf(v);
    }
    __syncthreads();
}

__device__ __forceinline__ float wave_sum(float v) {
#pragma unroll
    for (int o = 32; o > 0; o >>= 1) v += __shfl_xor(v, o);
    return v;
}

__device__ void phase_convert(const Args& a, int l, float* lds) {
    const int nconv = conv_total();
    const int n_s5 = 48, n_mem = 64;
    const int total = nconv + n_s5 + n_mem;
    const int tid = tidx();
    for (int t0 = blockIdx.x; t0 < nconv; t0 += 4 * gridDim.x) {
        ConvJob jb[4]; float v[4][8];
#pragma unroll
        for (int q = 0; q < 4; ++q) {
            jb[q] = conv_decode(a, l, t0 + q * (int)gridDim.x, nconv);
            if (jb[q].valid) {
#pragma unroll
                for (int i = 0; i < 8; ++i) { const int idx = i * 512 + tid, r = idx >> 6, c = idx & 63; v[q][i] = jb[q].s[(size_t)r * jb[q].N + c]; }
            }
        }
#pragma unroll
        for (int q = 0; q < 4; ++q) {
            if (jb[q].valid) {
#pragma unroll
                for (int i = 0; i < 8; ++i) { const int idx = i * 512 + tid, r = idx >> 6, c = idx & 63; lds[q * 4160 + r * 65 + c] = v[q][i]; }
            }
        }
        __syncthreads();
#pragma unroll
        for (int q = 0; q < 4; ++q) {
            if (jb[q].valid) {
#pragma unroll
                for (int i = 0; i < 4; ++i) {
                    const int idx = i * 512 + tid, rn = idx >> 5, ck = (idx & 31) * 2;
                    int n = jb[q].nbase + rn;
                    if (jb[q].glu) { n = (n < 768) ? ((n >> 7) * 256 + (n & 127)) : (((n - 768) >> 7) * 256 + 128 + ((n - 768) & 127)); }
                    *(unsigned*)(jb[q].d + (size_t)n * jb[q].ldd + ck) = cvt_pk_bf16(lds[q * 4160 + ck * 65 + rn], lds[q * 4160 + (ck + 1) * 65 + rn]);
                }
            }
        }
        __syncthreads();
    }
    for (int t = nconv + blockIdx.x; t < total; t += gridDim.x) {
        if (t < nconv + n_s5) {

            s5_param_tile(a, l, t - nconv, lds);
        } else {
            const int row = (t - nconv - n_s5) * 8 + (tidx() >> 6), lane = tidx() & 63;
            const float* x = inp(a, I_MEM) + (size_t)row * 1024; const float* g = inp(a, I_GMEM) + l * 1024;
            f32x4 v[4]; float ss = 0.f;
#pragma unroll
            for (int i = 0; i < 4; ++i) { v[i] = *(const f32x4*)(x + i * 256 + lane * 4); ss += v[i][0] * v[i][0] + v[i][1] * v[i][1] + v[i][2] * v[i][2] + v[i][3] * v[i][3]; }
            ss = wave_sum(ss); const float sc = rsqrtf(ss * (1.0f / 1024.0f) + EPS);
            bf16_t* o = (bf16_t*)(wsp(a) + WS_MEMN) + (size_t)row * 1024;
#pragma unroll
            for (int i = 0; i < 4; ++i) { const f32x4 gg = *(const f32x4*)(g + i * 256 + lane * 4); u32x2 w; w.x = cvt_pk_bf16(v[i][0] * sc * gg[0], v[i][1] * sc * gg[1]); w.y = cvt_pk_bf16(v[i][2] * sc * gg[2], v[i][3] * sc * gg[3]); *(u32x2*)(o + i * 256 + lane * 4) = w; }
        }
    }
}

__device__ void phase_prenorm(const float* __restrict__ x, const float* __restrict__ g, bf16_t* __restrict__ hb) {
    const int lane = tidx() & 63, w = tidx() >> 6;
    for (int t = blockIdx.x; t < LSEQ / 8; t += gridDim.x) {
        const int row = t * 8 + w;
        const float* xr = x + (size_t)row * 1024;
        f32x4 v[4]; float ss = 0.f;
#pragma unroll
        for (int i = 0; i < 4; ++i) { v[i] = *(const f32x4*)(xr + i * 256 + lane * 4); ss += v[i][0] * v[i][0] + v[i][1] * v[i][1] + v[i][2] * v[i][2] + v[i][3] * v[i][3]; }
        ss = wave_sum(ss); const float sc = rsqrtf(ss * (1.0f / 1024.0f) + EPS);
        bf16_t* o = hb + (size_t)row * 1024;
#pragma unroll
        for (int i = 0; i < 4; ++i) { const f32x4 gg = *(const f32x4*)(g + i * 256 + lane * 4); u32x2 wv; wv.x = cvt_pk_bf16(v[i][0] * sc * gg[0], v[i][1] * sc * gg[1]); wv.y = cvt_pk_bf16(v[i][2] * sc * gg[2], v[i][3] * sc * gg[3]); *(u32x2*)(o + i * 256 + lane * 4) = wv; }
    }
}

template <bool WITH_H>
__device__ void phase_postnorm(const float* xin, const bf16_t* __restrict__ y, const float* __restrict__ gpost, float* xout,
                               const float* __restrict__ gpre, bf16_t* __restrict__ hb) {
    const int lane = tidx() & 63, w = tidx() >> 6;
    f32x4 gp[2][2], gq[2][2];
#pragma unroll
    for (int i = 0; i < 2; ++i)
#pragma unroll
        for (int h = 0; h < 2; ++h) { gp[i][h] = *(const f32x4*)(gpost + i * 512 + lane * 8 + h * 4); if (WITH_H) gq[i][h] = *(const f32x4*)(gpre + i * 512 + lane * 8 + h * 4); }
    for (int t = blockIdx.x; t < LSEQ / 32; t += gridDim.x) {
        const int row0 = t * 32 + w * 4;
        u32x4 yv[4][2]; f32x4 xv[4][2][2];
#pragma unroll
        for (int r = 0; r < 4; ++r)
#pragma unroll
            for (int i = 0; i < 2; ++i) {
                yv[r][i] = *(const u32x4*)(y + (size_t)(row0 + r) * 1024 + i * 512 + lane * 8);
                xv[r][i][0] = *(const f32x4*)(xin + (size_t)(row0 + r) * 1024 + i * 512 + lane * 8);
                xv[r][i][1] = *(const f32x4*)(xin + (size_t)(row0 + r) * 1024 + i * 512 + lane * 8 + 4);
            }
#pragma unroll
        for (int r = 0; r < 4; ++r) {
            float yf[2][8]; float ss = 0.f;
#pragma unroll
            for (int i = 0; i < 2; ++i)
#pragma unroll
                for (int e = 0; e < 4; ++e) { yf[i][2 * e] = bflo(yv[r][i][e]); yf[i][2 * e + 1] = bfhi(yv[r][i][e]); ss += yf[i][2 * e] * yf[i][2 * e] + yf[i][2 * e + 1] * yf[i][2 * e + 1]; }
            ss = wave_sum(ss); const float sc = rsqrtf(ss * (1.0f / 1024.0f) + EPS);
            float s2 = 0.f;
#pragma unroll
            for (int i = 0; i < 2; ++i)
#pragma unroll
                for (int h = 0; h < 2; ++h) {
#pragma unroll
                    for (int e = 0; e < 4; ++e) { const float v = xv[r][i][h][e] + yf[i][h * 4 + e] * sc * gp[i][h][e]; xv[r][i][h][e] = v; s2 += v * v; }
                    *(f32x4*)(xout + (size_t)(row0 + r) * 1024 + i * 512 + lane * 8 + h * 4) = xv[r][i][h];
                }
            if (WITH_H) {
                s2 = wave_sum(s2); const float sc2 = rsqrtf(s2 * (1.0f / 1024.0f) + EPS);
#pragma unroll
                for (int i = 0; i < 2; ++i) {
                    f32x4 o0, o1;
#pragma unroll
                    for (int e = 0; e < 4; ++e) { o0[e] = xv[r][i][0][e] * sc2 * gq[i][0][e]; o1[e] = xv[r][i][1][e] * sc2 * gq[i][1][e]; }
                    u32x4 wv; wv[0] = cvt_pk_bf16(o0[0], o0[1]); wv[1] = cvt_pk_bf16(o0[2], o0[3]); wv[2] = cvt_pk_bf16(o1[0], o1[1]); wv[3] = cvt_pk_bf16(o1[2], o1[3]);
                    *(u32x4*)(hb + (size_t)(row0 + r) * 1024 + i * 512 + lane * 8) = wv;
                }
            }
        }
    }
}

#define WSYNC() __syncthreads()
template <int PASS>
__device__ void s5_item(const Args& a, int l, int item, float* wl  ) {
    const int lane = tidx() & 63, fr = lane & 15, fq = lane >> 4;
    const int g = item % 48, chunk = item / 48;
    const bf16_t* zA = (const bf16_t*)(wsp(a) + WS_ZA);
    const bf16_t* bbt = (const bf16_t*)(wsp(a) + WS_BBART) + (size_t)g * 128 * 16;
    const bf16_t* cm = (const bf16_t*)(wsp(a) + WS_CMAT) + (size_t)g * 16 * 128;
    const float* abar = (const float*)(wsp(a) + WS_ABAR);
    float* s5c = (float*)(wsp(a) + WS_S5C);
    const bf16x8 zero8 = {0, 0, 0, 0, 0, 0, 0, 0};
    bf16x8 bB[8];
#pragma unroll
    for (int cb = 0; cb < 8; ++cb) bB[cb] = (fq < 2) ? *(const bf16x8*)(bbt + (cb * 16 + fr) * 16 + fq * 8) : zero8;
    bf16x8 bC[4];
    float dsk = 0.f;
    if (PASS == 2) {
#pragma unroll
        for (int ks = 0; ks < 4; ++ks) bC[ks] = *(const bf16x8*)(cm + fr * 128 + ks * 32 + fq * 8);
        dsk = inp(a, I_SD)[l * 768 + g * 16 + fr];
    }
    const float ar = abar[(g * 64 + lane) * 2], ai = abar[(g * 64 + lane) * 2 + 1];
    float xr = 0.f, xi = 0.f;
    if (PASS == 2) { xr = s5c[((size_t)(chunk * 48 + g) * 64 + lane) * 2]; xi = s5c[((size_t)(chunk * 48 + g) * 64 + lane) * 2 + 1]; }
    const int t0 = chunk * S5_LC;
    bf16x8 aUn[2];
#pragma unroll
    for (int rb = 0; rb < 2; ++rb) aUn[rb] = (fq < 2) ? *(const bf16x8*)(zA + (size_t)(t0 + rb * 16 + fr) * ZAW + OFF_US + g * 16 + fq * 8) : zero8;
    for (int sub = 0; sub < S5_LC / 32; ++sub) {
        const int ts = t0 + sub * 32;
        bf16x8 aUc[2]; aUc[0] = aUn[0]; aUc[1] = aUn[1];
        if (sub + 1 < S5_LC / 32) {
#pragma unroll
            for (int rb = 0; rb < 2; ++rb) aUn[rb] = (fq < 2) ? *(const bf16x8*)(zA + (size_t)(ts + 32 + rb * 16 + fr) * ZAW + OFF_US + g * 16 + fq * 8) : zero8;
        }
        bf16_t uq[2][4];
        if (PASS == 2) {
#pragma unroll
            for (int rb = 0; rb < 2; ++rb)
#pragma unroll
                for (int j = 0; j < 4; ++j) uq[rb][j] = zA[(size_t)(ts + rb * 16 + fq * 4 + j) * ZAW + OFF_US + g * 16 + fr];
        }
#pragma unroll
        for (int rb = 0; rb < 2; ++rb) {
            const bf16x8 aU = aUc[rb];
#pragma unroll
            for (int cb = 0; cb < 8; ++cb) {
                f32x4 c = {0.f, 0.f, 0.f, 0.f};
                c = __builtin_amdgcn_mfma_f32_16x16x32_bf16(aU, bB[cb], c, 0, 0, 0);
#pragma unroll
                for (int j = 0; j < 4; ++j) wl[(rb * 16 + fq * 4 + j) * 132 + cb * 16 + fr] = c[j];
            }
        }
        WSYNC();
#pragma unroll 8
        for (int t = 0; t < 32; ++t) {
            const float br = wl[t * 132 + lane], bi = wl[t * 132 + 64 + lane];
            const float nr = ar * xr - ai * xi + br, ni = ar * xi + ai * xr + bi;
            xr = nr; xi = ni;
            if (PASS == 2) { wl[t * 132 + lane] = xr; wl[t * 132 + 64 + lane] = xi; }
        }
        WSYNC();
        if (PASS == 2) {
#pragma unroll
            for (int rb = 0; rb < 2; ++rb) {
                f32x4 c = {0.f, 0.f, 0.f, 0.f};
#pragma unroll
                for (int ks = 0; ks < 4; ++ks) {
                    const float* xp = wl + (rb * 16 + fr) * 132 + ks * 32 + fq * 8;
                    const f32x4 x0 = *(const f32x4*)xp, x1 = *(const f32x4*)(xp + 4);
                    union { bf16x8 v; unsigned u[4]; } A;
                    A.u[0] = cvt_pk_bf16(x0[0], x0[1]); A.u[1] = cvt_pk_bf16(x0[2], x0[3]); A.u[2] = cvt_pk_bf16(x1[0], x1[1]); A.u[3] = cvt_pk_bf16(x1[2], x1[3]);
                    c = __builtin_amdgcn_mfma_f32_16x16x32_bf16(A.v, bC[ks], c, 0, 0, 0);
                }
                bf16_t* gy = (bf16_t*)(wsp(a) + WS_GY);
#pragma unroll
                for (int j = 0; j < 4; ++j) {
                    const int tok = ts + rb * 16 + fq * 4 + j;
                    const float uu = bf2f(uq[rb][j]);
                    gy[(size_t)tok * 768 + g * 16 + fr] = f2bf(gelu_tanh(c[j] + dsk * uu));
                }
            }
            WSYNC();
        }
    }
    if (PASS == 1) { s5c[((size_t)(chunk * 48 + g) * 64 + lane) * 2] = xr; s5c[((size_t)(chunk * 48 + g) * 64 + lane) * 2 + 1] = xi; }
}

template <int PASS>
__device__ void lru_item(const Args& a, int l, int item, unsigned char* wlb  ) {
    const int lane = tidx() & 63, fr = lane & 15, fq = lane >> 4;
    const int n = item % 12, chunk = item / 12;
    const int ch = n * 64 + lane;
    const bf16_t* zA = (const bf16_t*)(wsp(a) + WS_ZA);
    float* xcf = (float*)wlb;
    float* abuf = (float*)(wlb + 4096);
    bf16_t* xcb = (bf16_t*)(wlb + 8192);
    const bf16_t* waT = (const bf16_t*)(wsp(a) + WS_WAT) + n * 4096;
    const bf16_t* wxT = (const bf16_t*)(wsp(a) + WS_WXT) + n * 4096;
    bf16x8 bWa[4][2], bWx[4][2];
    float ba4[4], bx4[4], sp4[4];
#pragma unroll
    for (int cb = 0; cb < 4; ++cb) {
#pragma unroll
        for (int ks = 0; ks < 2; ++ks) { bWa[cb][ks] = *(const bf16x8*)(waT + (cb * 16 + fr) * 64 + ks * 32 + fq * 8); bWx[cb][ks] = *(const bf16x8*)(wxT + (cb * 16 + fr) * 64 + ks * 32 + fq * 8); }
        const int cc = l * 768 + n * 64 + cb * 16 + fr;
        ba4[cb] = inp(a, I_LBA)[cc]; bx4[cb] = inp(a, I_LBX)[cc];
        const float lam = inp(a, I_LLAM)[cc];
        sp4[cb] = (lam < -20.f) ? -lam : log1pf(__expf(-lam));
    }
    const float w0 = inp(a, I_LCW)[(l * 4 + 0) * 768 + ch], w1 = inp(a, I_LCW)[(l * 4 + 1) * 768 + ch], w2 = inp(a, I_LCW)[(l * 4 + 2) * 768 + ch], w3 = inp(a, I_LCW)[(l * 4 + 3) * 768 + ch];
    const float cbias = inp(a, I_LCB)[l * 768 + ch];
    const int t0 = chunk * LRU_LC;
    float xm3 = 0.f, xm2 = 0.f, xm1 = 0.f;
    if (t0 > 0) { xm3 = bf2f(zA[(size_t)(t0 - 3) * ZAW + OFF_XA + ch]); xm2 = bf2f(zA[(size_t)(t0 - 2) * ZAW + OFF_XA + ch]); xm1 = bf2f(zA[(size_t)(t0 - 1) * ZAW + OFF_XA + ch]); }
    float* lp = (float*)(wsp(a) + WS_LRUP); float* lh = (float*)(wsp(a) + WS_LRUH);
    float h = 0.f, P = 1.f;
    if (PASS == 2) h = lh[(size_t)chunk * 768 + ch];
    bf16_t* ya = (bf16_t*)(wsp(a) + WS_YCAT) + YC_A;
    bf16_t xq[16], gq[16];
#pragma unroll
    for (int t = 0; t < 16; ++t) xq[t] = zA[(size_t)(t0 + t) * ZAW + OFF_XA + ch];
    for (int sub = 0; sub < LRU_LC / 16; ++sub) {
        const int ts = t0 + sub * 16;
        if (PASS == 2) {
#pragma unroll
            for (int t = 0; t < 16; ++t) gq[t] = zA[(size_t)(ts + t) * ZAW + OFF_GA + ch];
        }
#pragma unroll
        for (int t = 0; t < 16; ++t) {
            const float xv = bf2f(xq[t]);
            const float xc = cbias + w0 * xm3 + w1 * xm2 + w2 * xm1 + w3 * xv;
            xm3 = xm2; xm2 = xm1; xm1 = xv;
            xcf[t * 64 + lane] = xc; xcb[t * 72 + lane] = f2bf(xc);
        }
        if (sub + 1 < LRU_LC / 16) {
#pragma unroll
            for (int t = 0; t < 16; ++t) xq[t] = zA[(size_t)(ts + 16 + t) * ZAW + OFF_XA + ch];
        }
        asm volatile("s_waitcnt lgkmcnt(0)" ::: "memory");
        bf16x8 aX[2];
#pragma unroll
        for (int ks = 0; ks < 2; ++ks) aX[ks] = *(const bf16x8*)(xcb + fr * 72 + ks * 32 + fq * 8);
#pragma unroll
        for (int cb = 0; cb < 4; ++cb) {
            f32x4 cA = {0.f, 0.f, 0.f, 0.f}, cX = {0.f, 0.f, 0.f, 0.f};
            cA = __builtin_amdgcn_mfma_f32_16x16x32_bf16(aX[0], bWa[cb][0], cA, 0, 0, 0);
            cA = __builtin_amdgcn_mfma_f32_16x16x32_bf16(aX[1], bWa[cb][1], cA, 0, 0, 0);
            cX = __builtin_amdgcn_mfma_f32_16x16x32_bf16(aX[0], bWx[cb][0], cX, 0, 0, 0);
            cX = __builtin_amdgcn_mfma_f32_16x16x32_bf16(aX[1], bWx[cb][1], cX, 0, 0, 0);
#pragma unroll
            for (int j = 0; j < 4; ++j) {
                const int tok = fq * 4 + j, cc = cb * 16 + fr;
                const float r = sigmoidf_(cA[j] + ba4[cb]), ig = sigmoidf_(cX[j] + bx4[cb]);
                const float la = -8.0f * r * sp4[cb];
                const float av = fexp(la);
                const float xcv = xcf[tok * 64 + cc];
                const float uv = __builtin_amdgcn_sqrtf(fmaxf(1.0f - av * av, 0.0f)) * (ig * xcv);
                abuf[tok * 64 + cc] = av; xcf[tok * 64 + cc] = uv;
            }
        }
        asm volatile("s_waitcnt lgkmcnt(0)" ::: "memory");
#pragma unroll
        for (int t = 0; t < 16; ++t) {
            const float av = abuf[t * 64 + lane], uv = xcf[t * 64 + lane];
            h = av * h + uv; P *= av;
            if (PASS == 2) ya[(size_t)(ts + t) * YCW + ch] = f2bf(h * bf2f(gq[t]));
        }
        asm volatile("" ::: "memory");
    }
    if (PASS == 1) { lp[(size_t)chunk * 768 + ch] = P; lh[(size_t)chunk * 768 + ch] = h; }
}

__device__ void dil_attn_tile(const Args& a, int tile, unsigned char* lds) {
    const int tid = tidx(), w = tid >> 6, lane = tid & 63, fr = lane & 15, fq = lane >> 4;
    const int head = tile >> 7, blk = tile & 127;
    const int g = head >> 2;
    const int dil = (g == 0) ? 1 : (g == 1 ? 4 : 16);
    const int r = blk % dil, nb = blk / dil;
    const float slope = exp2f(-8.0f * (float)(head + 1) / 12.0f) * (float)dil;
    const bf16_t* zA = (const bf16_t*)(wsp(a) + WS_ZA);
    bf16_t* Ks = (bf16_t*)lds;
    bf16_t* Vt = (bf16_t*)(lds + 256 * 144);
    constexpr int KS = 72, VS = 264;
    const size_t tq = (size_t)(nb * 128 + w * 16 + fr) * dil + r;
    bf16x8 bQ[2];
#pragma unroll
    for (int ks = 0; ks < 2; ++ks) bQ[ks] = *(const bf16x8*)(zA + tq * ZAW + OFF_Q + head * 64 + ks * 32 + fq * 8);
    const bf16x8 zero8 = {0, 0, 0, 0, 0, 0, 0, 0};
#pragma unroll
    for (int i = 0; i < 4; ++i) {
        const int c = i * 512 + tid, key = c >> 3, part = c & 7;
        const int kidx = nb * 128 + key - 128;
        bf16x8 kv = zero8, vv = zero8;
        if (kidx >= 0) {
            const size_t tok = (size_t)kidx * dil + r;
            kv = *(const bf16x8*)(zA + tok * ZAW + OFF_K + head * 64 + part * 8);
            vv = *(const bf16x8*)(zA + tok * ZAW + OFF_V + head * 64 + part * 8);
        }
        *(bf16x8*)(Ks + key * KS + part * 8) = kv;
#pragma unroll
        for (int e = 0; e < 8; ++e) Vt[(part * 8 + e) * VS + key] = (bf16_t)vv[e];
    }
    __syncthreads();
    f32x4 S[9];
    float mx = -1e30f;
#pragma unroll
    for (int kb = 0; kb < 9; ++kb) {
        f32x4 c = {0.f, 0.f, 0.f, 0.f};
#pragma unroll
        for (int ks = 0; ks < 2; ++ks) {
            const bf16x8 aK = *(const bf16x8*)(Ks + (w * 16 + kb * 16 + fr) * KS + ks * 32 + fq * 8);
            c = __builtin_amdgcn_mfma_f32_16x16x32_bf16(aK, bQ[ks], c, 0, 0, 0);
        }
#pragma unroll
        for (int j = 0; j < 4; ++j) {
            const int ki = w * 16 + kb * 16 + fq * 4 + j;
            const int dist = fr + 128 - kb * 16 - fq * 4 - j;
            const bool valid = (dist >= 0) && (dist <= 128) && (nb * 128 + ki - 128 >= 0);
            const float s = valid ? (c[j] * 0.125f - slope * (float)dist) : -1e30f;
            c[j] = s; mx = fmaxf(mx, s);
        }
        S[kb] = c;
        __builtin_amdgcn_sched_barrier(0);
    }
    mx = fmaxf(mx, __shfl_xor(mx, 16)); mx = fmaxf(mx, __shfl_xor(mx, 32));
    float lsum = 0.f;
    unsigned pk[9][2];
#pragma unroll
    for (int kb = 0; kb < 9; ++kb) {
        float p[4];
#pragma unroll
        for (int j = 0; j < 4; ++j) { p[j] = __expf(S[kb][j] - mx); lsum += p[j]; }
        pk[kb][0] = cvt_pk_bf16(p[0], p[1]); pk[kb][1] = cvt_pk_bf16(p[2], p[3]);
    }
    lsum += __shfl_xor(lsum, 16); lsum += __shfl_xor(lsum, 32);
    f32x4 O[4];
#pragma unroll
    for (int db = 0; db < 4; ++db) O[db] = (f32x4){0.f, 0.f, 0.f, 0.f};
#pragma unroll
    for (int pp = 0; pp < 5; ++pp) {
        union { bf16x8 v; unsigned u[4]; } B;
        B.u[0] = pk[2 * pp][0]; B.u[1] = pk[2 * pp][1];
        if (pp < 4) { B.u[2] = pk[2 * pp + 1][0]; B.u[3] = pk[2 * pp + 1][1]; } else { B.u[2] = 0; B.u[3] = 0; }
#pragma unroll
        for (int db = 0; db < 4; ++db) {
            union { bf16x8 v; u32x2 h[2]; } A;
            A.h[0] = *(const u32x2*)(Vt + (db * 16 + fr) * VS + w * 16 + (2 * pp) * 16 + fq * 4);
            if (pp < 4) A.h[1] = *(const u32x2*)(Vt + (db * 16 + fr) * VS + w * 16 + (2 * pp + 1) * 16 + fq * 4); else A.h[1] = (u32x2){0u, 0u};
            O[db] = __builtin_amdgcn_mfma_f32_16x16x32_bf16(A.v, B.v, O[db], 0, 0, 0);
        }
    }
    const float inv = 1.0f / lsum;
    bf16_t* oatt = (bf16_t*)(wsp(a) + WS_OATT);
#pragma unroll
    for (int db = 0; db < 4; ++db) {
        u32x2 wv; wv.x = cvt_pk_bf16(O[db][0] * inv, O[db][1] * inv); wv.y = cvt_pk_bf16(O[db][2] * inv, O[db][3] * inv);
        *(u32x2*)(oatt + tq * 768 + head * 64 + db * 16 + fq * 4) = wv;
    }
    if (fq == 0) ((float*)(wsp(a) + WS_LSE))[tq * 12 + head] = mx + __logf(lsum);
    __syncthreads();
}

__device__ void cross_attn_tile(const Args& a, int b, int tile, unsigned char* lds) {
    const int tid = tidx(), w = tid >> 6, lane = tid & 63, fr = lane & 15, fq = lane >> 4;
    const int hx = tile >> 7, qb = tile & 127;
    const bf16_t* zA = (const bf16_t*)(wsp(a) + WS_ZA);
    const bf16_t* kvm = (const bf16_t*)(wsp(a) + WS_KVM) + (size_t)b * 256 * 1536;
    constexpr int KS = 200, VS = 136;
    bf16_t* Ks = (bf16_t*)lds;
    bf16_t* Vt = (bf16_t*)(lds + 51200);
    const size_t tq = (size_t)qb * 128 + w * 16 + fr;
    bf16x8 bQ[6];
#pragma unroll
    for (int ks = 0; ks < 6; ++ks) bQ[ks] = *(const bf16x8*)(zA + tq * ZAW + OFF_XQ + hx * 192 + ks * 32 + fq * 8);
    f32x4 O[12];
#pragma unroll
    for (int db = 0; db < 12; ++db) O[db] = (f32x4){0.f, 0.f, 0.f, 0.f};
    float mrun = -1e30f, lrun = 0.f;
    const float scale = 0.07216878364870322f;
#pragma unroll 1
    for (int hf = 0; hf < 2; ++hf) {
#pragma unroll 2
        for (int i = 0; i < 6; ++i) {
            const int c = i * 512 + tid, key = c / 24, part = c % 24;
            const bf16_t* src = kvm + (size_t)(hf * 128 + key) * 1536 + hx * 192 + part * 8;
            *(bf16x8*)(Ks + key * KS + part * 8) = *(const bf16x8*)(src);
            const bf16x8 vv = *(const bf16x8*)(src + 768);
#pragma unroll
            for (int e = 0; e < 8; ++e) Vt[(part * 8 + e) * VS + key] = (bf16_t)vv[e];
        }
        __syncthreads();
        f32x4 S[8];
        float mx = -1e30f;
#pragma unroll
        for (int kb = 0; kb < 8; ++kb) {
            f32x4 c = {0.f, 0.f, 0.f, 0.f};
#pragma unroll
            for (int ks = 0; ks < 6; ++ks) {
                const bf16x8 aK = *(const bf16x8*)(Ks + (kb * 16 + fr) * KS + ks * 32 + fq * 8);
                c = __builtin_amdgcn_mfma_f32_16x16x32_bf16(aK, bQ[ks], c, 0, 0, 0);
            }
#pragma unroll
            for (int j = 0; j < 4; ++j) { c[j] *= scale; mx = fmaxf(mx, c[j]); }
            S[kb] = c;
        }
        mx = fmaxf(mx, __shfl_xor(mx, 16)); mx = fmaxf(mx, __shfl_xor(mx, 32));
        const float mnew = fmaxf(mrun, mx);
        const float alpha = __expf(mrun - mnew);
        mrun = mnew;
        float lsum = 0.f;
        unsigned pk[8][2];
#pragma unroll
        for (int kb = 0; kb < 8; ++kb) {
            float p[4];
#pragma unroll
            for (int j = 0; j < 4; ++j) { p[j] = __expf(S[kb][j] - mnew); lsum += p[j]; }
            pk[kb][0] = cvt_pk_bf16(p[0], p[1]); pk[kb][1] = cvt_pk_bf16(p[2], p[3]);
        }
        lsum += __shfl_xor(lsum, 16); lsum += __shfl_xor(lsum, 32);
        lrun = lrun * alpha + lsum;
#pragma unroll
        for (int db = 0; db < 12; ++db) { O[db][0] *= alpha; O[db][1] *= alpha; O[db][2] *= alpha; O[db][3] *= alpha; }
#pragma unroll
        for (int pp = 0; pp < 4; ++pp) {
            union { bf16x8 v; unsigned u[4]; } B;
            B.u[0] = pk[2 * pp][0]; B.u[1] = pk[2 * pp][1]; B.u[2] = pk[2 * pp + 1][0]; B.u[3] = pk[2 * pp + 1][1];
#pragma unroll
            for (int db = 0; db < 12; ++db) {
                union { bf16x8 v; u32x2 h[2]; } A;
                A.h[0] = *(const u32x2*)(Vt + (db * 16 + fr) * VS + (2 * pp) * 16 + fq * 4);
                A.h[1] = *(const u32x2*)(Vt + (db * 16 + fr) * VS + (2 * pp + 1) * 16 + fq * 4);
                O[db] = __builtin_amdgcn_mfma_f32_16x16x32_bf16(A.v, B.v, O[db], 0, 0, 0);
            }
        }
        __syncthreads();
    }
    const float inv = 1.0f / lrun;
    bf16_t* yx = (bf16_t*)(wsp(a) + WS_YCAT) + YC_X;
#pragma unroll
    for (int db = 0; db < 12; ++db) {
        u32x2 wv; wv.x = cvt_pk_bf16(O[db][0] * inv, O[db][1] * inv); wv.y = cvt_pk_bf16(O[db][2] * inv, O[db][3] * inv);
        *(u32x2*)(yx + tq * YCW + hx * 192 + db * 16 + fq * 4) = wv;
    }
}

__device__ void combine_tile(const Args& a, int tile) {
    const int tid = tidx();
    const size_t tok = (size_t)tile * 16 + (tid >> 5);
    const int j = (tid >> 3) & 3, part = tid & 7;
    const float* lse = (const float*)(wsp(a) + WS_LSE) + tok * 12;
    const float l0 = lse[j], l1 = lse[4 + j], l2 = lse[8 + j];
    const float m = fmaxf(l0, fmaxf(l1, l2));
    float w0 = __expf(l0 - m), w1 = __expf(l1 - m), w2 = __expf(l2 - m);
    const float inv = 1.0f / (w0 + w1 + w2); w0 *= inv; w1 *= inv; w2 *= inv;
    const bf16_t* o = (const bf16_t*)(wsp(a) + WS_OATT) + tok * 768 + j * 64 + part * 8;
    const u32x4 a0 = *(const u32x4*)(o), a1 = *(const u32x4*)(o + 256), a2 = *(const u32x4*)(o + 512);
    u32x4 rr;
#pragma unroll
    for (int e = 0; e < 4; ++e) {
        const float lo = w0 * bflo(a0[e]) + w1 * bflo(a1[e]) + w2 * bflo(a2[e]);
        const float hi = w0 * bfhi(a0[e]) + w1 * bfhi(a1[e]) + w2 * bfhi(a2[e]);
        rr[e] = cvt_pk_bf16(lo, hi);
    }
    *(u32x4*)((bf16_t*)(wsp(a) + WS_YCAT) + tok * YCW + YC_B + j * 64 + part * 8) = rr;
}

constexpr int N_S5_TILES = S5_NCH * 48 / 8;
constexpr int N_LRU_TILES = LRU_NCH * 12 / 8;
constexpr int N_DIL_TILES = 12 * 128;
constexpr int N_X_TILES = 4 * 128;
constexpr int N_COMB_TILES = LSEQ / 16;

#ifndef MIXSEL
#define MIXSEL 15
#endif
__device__ void phase_mix1(const Args& a, int l, int b, unsigned char* lds) {
    const int w = tidx() >> 6;
    for (int t = blockIdx.x; t < N_S5_TILES; t += gridDim.x) s5_item<1>(a, l, t * 8 + w, (float*)(lds + w * 16896));
    asm volatile("" ::: "memory"); __builtin_amdgcn_sched_barrier(0);
    for (int t = blockIdx.x; t < N_LRU_TILES; t += gridDim.x) lru_item<1>(a, l, t * 8 + w, lds + w * 16896);
}
__device__ void phase_carry(const Args& a);
__device__ void phase_mixB(const Args& a, int l, int b, unsigned char* lds) {
    if (blockIdx.x < 8) {
        phase_carry(a);
        for (int t = N_X_TILES - 16 + (int)blockIdx.x; t < N_X_TILES; t += 8) cross_attn_tile(a, b, t, lds);
        return;
    }
    const int nb = gridDim.x - 8, bi = blockIdx.x - 8;
    for (int t = bi; t < N_X_TILES - 16; t += nb) cross_attn_tile(a, b, t, lds);
    asm volatile("" ::: "memory"); __builtin_amdgcn_sched_barrier(0);
    for (int t = bi; t < N_DIL_TILES; t += nb) dil_attn_tile(a, t, lds);
}
__device__ void phase_mix2(const Args& a, int l, unsigned char* lds) {
    const int w = tidx() >> 6;
    DM(4) for (int t = blockIdx.x; t < N_S5_TILES; t += gridDim.x) s5_item<2>(a, l, t * 8 + w, (float*)(lds + w * 16896));
    DM(5) for (int t = blockIdx.x; t < N_LRU_TILES; t += gridDim.x) lru_item<2>(a, l, t * 8 + w, lds + w * 16896);
    DM(6) for (int t = blockIdx.x; t < N_COMB_TILES; t += gridDim.x) combine_tile(a, t);
}

__device__ void phase_carry(const Args& a) {
    const int gt = blockIdx.x * 512 + tidx();
    if (gt < 3072) {
        float* s5c = (float*)(wsp(a) + WS_S5C);
        const float* abarl = (const float*)(wsp(a) + WS_ABARL);
        const float ar = abarl[gt * 2], ai = abarl[gt * 2 + 1];
        float xr = 0.f, xi = 0.f;
#pragma unroll 8
        for (int c = 0; c < S5_NCH; ++c) {
            float* p = s5c + ((size_t)c * 3072 + gt) * 2;
            const float er = p[0], ei = p[1];
            p[0] = xr; p[1] = xi;
            const float nr = ar * xr - ai * xi + er, ni = ar * xi + ai * xr + ei;
            xr = nr; xi = ni;
        }
    } else if (gt < 3072 + 768) {
        const int ch = gt - 3072;
        float* lp = (float*)(wsp(a) + WS_LRUP); float* lh = (float*)(wsp(a) + WS_LRUH);
        float h = 0.f;
#pragma unroll 8
        for (int c = 0; c < LRU_NCH; ++c) {
            const float P = lp[(size_t)c * 768 + ch], H = lh[(size_t)c * 768 + ch];
            lh[(size_t)c * 768 + ch] = h;
            h = P * h + H;
        }
    }
}

__device__ void phase_ffn_act(const Args& a, int l) {
    const bf16_t* up = (const bf16_t*)(wsp(a) + WS_UP);
    bf16_t* act = (bf16_t*)(wsp(a) + WS_ACT);
    const int total = (DFF / 8) * (LSEQ / 16);
    for (int it = blockIdx.x * 512 + tidx(); it < total; it += gridDim.x * 512) {
        const int cg8 = it % (DFF / 8), run = it / (DFF / 8);
        const int c0 = cg8 * 8, t0 = run * 16;
        float w0[8], w1[8], w2[8], cb[8];
#pragma unroll
        for (int e = 0; e < 8; ++e) { w0[e] = inp(a, I_FCW)[(l * 3 + 0) * DFF + c0 + e]; w1[e] = inp(a, I_FCW)[(l * 3 + 1) * DFF + c0 + e]; w2[e] = inp(a, I_FCW)[(l * 3 + 2) * DFF + c0 + e]; cb[e] = inp(a, I_FCB)[l * DFF + c0 + e]; }
        u32x4 g2 = {0u, 0u, 0u, 0u}, g1 = {0u, 0u, 0u, 0u};
        if (t0 > 0) { g2 = *(const u32x4*)(up + (size_t)(t0 - 2) * 6144 + DFF + c0); g1 = *(const u32x4*)(up + (size_t)(t0 - 1) * 6144 + DFF + c0); }
        for (int tb = 0; tb < 16; tb += 4) {
            u32x4 gq[4], vq[4];
#pragma unroll
            for (int q = 0; q < 4; ++q) { gq[q] = *(const u32x4*)(up + (size_t)(t0 + tb + q) * 6144 + DFF + c0); vq[q] = *(const u32x4*)(up + (size_t)(t0 + tb + q) * 6144 + c0); }
#pragma unroll
            for (int q = 0; q < 4; ++q) {
                const u32x4 g0 = gq[q], vv = vq[q];
                u32x4 rr;
#pragma unroll
                for (int e = 0; e < 4; ++e) {
                    const float glo = cb[2 * e] + w0[2 * e] * bflo(g2[e]) + w1[2 * e] * bflo(g1[e]) + w2[2 * e] * bflo(g0[e]);
                    const float ghi = cb[2 * e + 1] + w0[2 * e + 1] * bfhi(g2[e]) + w1[2 * e + 1] * bfhi(g1[e]) + w2[2 * e + 1] * bfhi(g0[e]);
                    rr[e] = cvt_pk_bf16(bflo(vv[e]) * gelu_tanh(glo), bfhi(vv[e]) * gelu_tanh(ghi));
                }
                *(u32x4*)(act + (size_t)(t0 + tb + q) * DFF + c0) = rr;
                g2 = g1; g1 = g0;
            }
        }
    }
}


#define XB_TMO      128
#define XB_XCNT(j)  (256  + 64 * (j))
#define XB_XSUB(j)  (1280 + 64 * (j))
#define XB_XGEN(j)  (2304 + 64 * (j))
#define XB_TOP      3328
#define XB_TOPGEN   3392
#define XCD_BAR_WORDS 3456
#define XB_SPIN_CAP (1u << 18)
#define LAS __attribute__((address_space(3)))
__device__ __forceinline__ unsigned xb_ld(unsigned* p)              { return __hip_atomic_load(p, __ATOMIC_RELAXED, __HIP_MEMORY_SCOPE_AGENT); }
__device__ __forceinline__ unsigned xb_add(unsigned* p, unsigned v) { return __hip_atomic_fetch_add(p, v, __ATOMIC_RELAXED, __HIP_MEMORY_SCOPE_AGENT); }
__device__ __forceinline__ unsigned xb_xcc_id() { return (unsigned)__builtin_amdgcn_s_getreg((3 << 11) | 20) & 0xFu; }
#define XB_SPIN(cond, bar) do { unsigned _sp = 0; while (cond) { __builtin_amdgcn_s_sleep(1); \
    if ((++_sp & 255u) == 0u) { if (xb_ld(&(bar)[XB_TMO])) break; if (_sp > XB_SPIN_CAP) { atomicAdd(&(bar)[XB_TMO], 1u); break; } } } } while (0)
struct XcdBarrier { unsigned* bar; unsigned x; volatile LAS unsigned* st; };
__device__ __forceinline__ XcdBarrier xcd_barrier_post(unsigned* bar, volatile LAS unsigned* st) {
    XcdBarrier b; b.bar = bar; b.x = xb_xcc_id(); b.st = st;
    if (threadIdx.x == 0) (void)xb_add(&bar[XB_XCNT(b.x)], 1u);
    return b;
}
__device__ __forceinline__ void xcd_barrier_complete(unsigned* bar, unsigned x, unsigned& nloc, unsigned& nx) {
    const unsigned G = gridDim.x * gridDim.y * gridDim.z;
    unsigned sum, cnt, mine, sp = 0u;
    for (;;) {
        sum = 0u; cnt = 0u; mine = 0u;
#pragma unroll
        for (unsigned j = 0; j < 16; ++j) { const unsigned c = xb_ld(&bar[XB_XCNT(j)]); sum += c; cnt += (c > 0u) ? 1u : 0u; mine = (j == x) ? c : mine; }
        if (sum == G) break;
        __builtin_amdgcn_s_sleep(1);
        if ((++sp & 255u) == 0u) { if (xb_ld(&bar[XB_TMO])) break; if (sp > XB_SPIN_CAP) { atomicAdd(&bar[XB_TMO], 1u); break; } }
    }
    nloc = mine > 0u ? mine : 1u; nx = cnt > 0u ? cnt : 1u;
}
__device__ __forceinline__ void xcd_barrier(const XcdBarrier& b) {
    asm volatile("s_waitcnt vmcnt(0)" ::: "memory");
    __syncthreads();
    if (threadIdx.x == 0) {
        unsigned* bar = b.bar;
        __builtin_amdgcn_s_waitcnt(0);
        unsigned nloc = b.st[0], nx = b.st[1];
        if (nloc == 0u) { xcd_barrier_complete(bar, b.x, nloc, nx); b.st[0] = nloc; b.st[1] = nx; }
        const unsigned old = xb_add(&bar[XB_XSUB(b.x)], 1u);
        const unsigned gen = old / nloc;
        if (old + 1u == (gen + 1u) * nloc) {
            __builtin_amdgcn_fence(__ATOMIC_RELEASE, "agent");
            asm volatile("s_waitcnt vmcnt(0)" ::: "memory");
            const unsigned og = xb_add(&bar[XB_TOP], 1u);
            const unsigned tg = og / nx;
            if (og + 1u == (tg + 1u) * nx) xb_add(&bar[XB_TOPGEN], 1u);
            else XB_SPIN(xb_ld(&bar[XB_TOPGEN]) == tg, bar);
            __builtin_amdgcn_fence(__ATOMIC_ACQUIRE, "agent");
            xb_add(&bar[XB_XGEN(b.x)], 1u);
            asm volatile("s_waitcnt vmcnt(0)" ::: "memory");
        } else {
            XB_SPIN(xb_ld(&bar[XB_XGEN(b.x)]) == gen, bar);
            __builtin_amdgcn_fence(__ATOMIC_ACQUIRE, "agent");
            asm volatile("s_waitcnt vmcnt(0)" ::: "memory");
        }
    }
    __syncthreads();
}

constexpr int PH_PER_BATCH = 16, PH_PER_LAYER = 2 + 2 * PH_PER_BATCH, PH_TOTAL = 2 * PH_PER_LAYER;


__global__ void __launch_bounds__(512, 2) mega_fwd(Args a) {
    extern __shared__ __attribute__((aligned(16))) unsigned char shm[];
    cg::grid_group grid = cg::this_grid();
    if (a.ph_lo < 0) grid.sync();
    if (threadIdx.x < 4) ((volatile LAS unsigned*)(shm + 135168))[threadIdx.x] = 0u;
    __syncthreads();
    XcdBarrier xbar = xcd_barrier_post((unsigned*)(GAS unsigned*)(a.ws + WS_BAR), (volatile LAS unsigned*)(shm + 135168));
    bool redo = false;
    for (int ph = a.ph_lo; ph < a.ph_hi; ++ph) {
        unsigned char* ws = wsp(a);
        const int l = ph / PH_PER_LAYER, r = ph % PH_PER_LAYER;
        const int b = (r >= 2) ? (r - 2) / PH_PER_BATCH : 0, s = (r >= 2) ? (r - 2) % PH_PER_BATCH : (r == 0 ? 100 : 101);
        if ((s >= 7 && s <= 9) || s == 101 || (s == 0 && b == 1)) continue;
        const size_t boff = (size_t)b * LSEQ * 1024;
        pg8::Gemm g; g.A = nullptr; g.Bt = nullptr; g.M = LSEQ; g.N = 1024; g.K = 1024;
        EpiUni E; E.mode = -1; E.O = nullptr; E.ld = 1024; E.zG = (const bf16_t*)(ws + WS_ZG); E.goff = 0; E.O2 = nullptr;
        switch (s) {
        case 1: g.A = (const bf16_t*)(ws + WS_HB); g.Bt = (const bf16_t*)(ws + WS_WINT); g.N = NIN; g.K = 1024; E.mode = M_WIN; E.O = ws + WS_ZA; E.O2 = (bf16_t*)(ws + WS_ZG); break;
        case 5: g.A = (const bf16_t*)(ws + WS_GY); g.Bt = (const bf16_t*)(ws + WS_GLUT); g.N = 1536; g.K = 768; E.mode = M_GLU; E.O = (bf16_t*)(ws + WS_YCAT) + YC_C; break;
        case 6: g.A = (const bf16_t*)(ws + WS_YCAT); g.Bt = (const bf16_t*)(ws + WS_PAT); g.K = YCW; E.mode = M_MERGE; E.O = ws + WS_MB; break;
        case 10: g.A = (const bf16_t*)(ws + WS_MB); g.Bt = (const bf16_t*)(ws + WS_WOUTT); g.K = 1024; E.mode = M_BF16; E.O = ws + WS_YOUT1; E.ld = 1024; break;
        case 12: g.A = (const bf16_t*)(ws + WS_HB); g.Bt = (const bf16_t*)(ws + WS_UPT); g.N = 6144; g.K = 1024; E.mode = M_BF16; E.O = ws + WS_UP; E.ld = 6144; break;
        case 14: g.A = (const bf16_t*)(ws + WS_ACT); g.Bt = (const bf16_t*)(ws + WS_DOWNT); g.K = 3072; E.mode = M_BF16; E.O = ws + WS_YOUT2; E.ld = 1024; break;
        default: break;
        }
        const int sidx = (s >= 100) ? s - 84 : s;
        const int reps = ((DUPMASK >> sidx) & 1) ? 2 : 1;
        for (int rep = 0; rep < reps; ++rep) {
        if (rep > 0) xcd_barrier(xbar);
        if (E.mode >= 0) {
            const int ngemm = (s == 1 && b == 0) ? 2 : 1;
            for (int gi = 0; gi < ngemm; ++gi) {
                pg8::StaticOrder S;
                if (gi == 0) S.init(g.M, g.N, (int)gridDim.x, (int)blockIdx.x);
                else {
                    g.A = (const bf16_t*)(ws + WS_MEMN); g.Bt = (const bf16_t*)(ws + WS_WKVT); g.M = 512; g.N = 1536; g.K = 1024;
                    E.mode = M_BF16; E.O = ws + WS_KVM; E.ld = 1536;
                    const int c2 = (int)blockIdx.x - 64;
                    S.init(512, 1536, 12, (c2 >= 0 && c2 < 12) ? c2 : (1 << 24));
                }
                if (PH_ON(1)) pg8::gemm_phase<EpiUni>((PG8_LAS unsigned char*)shm, g, S, E);
            }
        }
        if (E.mode < 0 || s == 0) {
            const float* xin = (l == 0 ? inp(a, I_X) : (const float*)outp(a)) + boff;
            float* xout = outp(a) + boff;
            if (s == 100) { if (PH_ON(100)) phase_convert(a, l, (float*)shm); }
            else if (s == 0) { if (PH_ON(0)) phase_prenorm(xin, inp(a, I_GMIXPRE) + l * 1024, (bf16_t*)(ws + WS_HB)); }
            else if (s == 2) { if (PH_ON(2)) phase_mix1(a, l, b, shm); }
            else if (s == 3) { if (PH_ON(3)) phase_mixB(a, l, b, shm); }
            else if (s == 4) { if (PH_ON(4)) phase_mix2(a, l, shm); }
            else if (s == 11) { if (PH_ON(11)) phase_postnorm<true>(xin, (const bf16_t*)(ws + WS_YOUT1), inp(a, I_GMIXPOST) + l * 1024, xout, inp(a, I_GMLPPRE) + l * 1024, (bf16_t*)(ws + WS_HB)); }
            else if (s == 13) { if (PH_ON(13)) phase_ffn_act(a, l); }
            else if (s == 15) {
                if (PH_ON(15)) phase_postnorm<false>(xout, (const bf16_t*)(ws + WS_YOUT2), inp(a, I_GMLPPOST) + l * 1024, xout, nullptr, nullptr);
                if (b == 0) {
                    const float* xin1 = (l == 0 ? inp(a, I_X) : (const float*)outp(a)) + (size_t)LSEQ * 1024;
                    phase_prenorm(xin1, inp(a, I_GMIXPRE) + l * 1024, (bf16_t*)(ws + WS_HB));
                }
            }
        }
        }
        if (ph + 1 < a.ph_hi) xcd_barrier(xbar);
#ifdef DUPMERGE
        if (s == 6 && !redo) { redo = true; ph -= 1; } else if (s == 10) redo = false;
#endif
    }
}

extern "C" void kernel_launch(void* const* d_in, const int* in_sizes, int n_in, void* d_out, int out_size, void* d_ws, size_t ws_size, hipStream_t stream) {
    static int grid = 0;
    if (grid == 0) {
        if (n_in != 34 || ws_size < WS_END) { fprintf(stderr, "kernel_launch: unexpected n_in %d or ws_size %zu (< %zu)\n", n_in, ws_size, (size_t)WS_END); grid = -1; return; }
        int dev = 0, cus = 0, per_cu = 0;
        hipGetDevice(&dev);
        hipDeviceGetAttribute(&cus, hipDeviceAttributeMultiprocessorCount, dev);
        hipFuncSetAttribute((const void*)mega_fwd, hipFuncAttributeMaxDynamicSharedMemorySize, LDS_BYTES);
        hipOccupancyMaxActiveBlocksPerMultiprocessor(&per_cu, (const void*)mega_fwd, 512, LDS_BYTES);
        if (per_cu < 1) per_cu = 1;
        grid = cus * per_cu;
        (void)hipGetLastError();
    }
    if (grid < 0) return;
    Args a{};
    for (int i = 0; i < 34; ++i) a.in[i] = (const float*)d_in[i];
    a.out = (float*)d_out; a.ws = (unsigned char*)d_ws;
    (void)hipMemsetAsync((unsigned char*)d_ws + WS_BAR, 0, 16384, stream);
#if MK_SINGLE
    a.ph_lo = 0; a.ph_hi = PH_TOTAL;
    void* args[] = {&a};
    hipError_t e = hipLaunchCooperativeKernel((const void*)mega_fwd, dim3(grid), dim3(512), args, LDS_BYTES, stream);
    if (e != hipSuccess) fprintf(stderr, "cooperative launch failed: %s (grid %d)\n", hipGetErrorString(e), grid);
#else
    for (int ph = 0; ph < PH_TOTAL; ++ph) {
        a.ph_lo = ph; a.ph_hi = ph + 1;
        hipLaunchKernelGGL(mega_fwd, dim3(grid), dim3(512), LDS_BYTES, stream, a);
    }
#endif
}
```
